# Optimizing an MI355X kernel written in HIP

```python
import jax, jax.numpy as jnp
from jax import lax
import numpy as np

D_MODEL = 2048
BATCH = 2
SEQ = 8192
DEPTH = 1

GRID_W = 64
CTX_LEN = 256
D_FF = 5632
N_MOD = 9
RET_HEADS = 8
RET_DK = 64
RET_DV = 128
RET_CHUNK = 128
RET_ROPE_BASE = 10000.0
MLA_HEADS = 8
MLA_Q_RANK = 512
MLA_KV_RANK = 256
MLA_NOPE = 128
MLA_ROPE = 64
MLA_V = 128
AXIAL_BASE = 10000.0
Q_BLOCK = 128
RMS_EPS = 1e-6
GN_EPS = 1e-5
MIX_OUT = RET_HEADS * RET_DV + MLA_HEADS * MLA_V
SPLITS = (RET_HEADS * RET_DK, RET_HEADS * RET_DK, RET_HEADS * RET_DV, RET_HEADS * RET_DV,
          MLA_Q_RANK, MLA_KV_RANK, MLA_ROPE)
MIX_IN = sum(SPLITS)

kernel_name = "hymba_retention_mla_macaron_dit"


def rms_norm(x, g):
    xf = x.astype(jnp.float32)
    y = xf * lax.rsqrt(jnp.mean(xf * xf, axis=-1, keepdims=True) + RMS_EPS)
    return (y * g.astype(jnp.float32)).astype(x.dtype)


def modulate(h, shift, scale):
    return h * (1.0 + scale) + shift


def swiglu(h, w_in, w_out):
    g, u = jnp.split(h @ w_in, 2, axis=-1)
    return (jax.nn.silu(g) * u) @ w_out


def rope_tables(pos, dim, base):
    inv = base ** (-jnp.arange(0, dim, 2, dtype=jnp.float32) / dim)
    ang = pos.astype(jnp.float32)[:, None] * inv[None, :]
    return jnp.cos(ang)[:, None, :], jnp.sin(ang)[:, None, :]


def rotate(x, cos, sin):
    x1, x2 = jnp.split(x, 2, axis=-1)
    return jnp.concatenate([x1 * cos - x2 * sin, x2 * cos + x1 * sin], axis=-1).astype(x.dtype)


def axial_rope(x, row_tab, col_tab):
    xr, xc = jnp.split(x, 2, axis=-1)
    return jnp.concatenate([rotate(xr, *row_tab), rotate(xc, *col_tab)], axis=-1)


def project(h, w_in, q_norm_g, w_uq, kv_norm_g, w_ukv):
    b, n, _ = h.shape
    idx = [int(i) for i in np.cumsum(SPLITS)[:-1]]
    rq, rk, rv, rg, cq, ckv, kr = jnp.split(h @ w_in, idx, axis=-1)
    rq = rq.reshape(b, n, RET_HEADS, RET_DK)
    rk = rk.reshape(b, n, RET_HEADS, RET_DK) * (RET_DK ** -0.5)
    rv = rv.reshape(b, n, RET_HEADS, RET_DV)
    q = (rms_norm(cq, q_norm_g) @ w_uq).reshape(b, n, MLA_HEADS, MLA_NOPE + MLA_ROPE)
    kv = (rms_norm(ckv, kv_norm_g) @ w_ukv).reshape(b, n, MLA_HEADS, MLA_NOPE + MLA_V)
    q_nope, q_rope = q[..., :MLA_NOPE], q[..., MLA_NOPE:]
    k_nope, v = kv[..., :MLA_NOPE], kv[..., MLA_NOPE:]
    k_rope = kr[:, :, None, :]
    return rq, rk, rv, rg, q_nope, q_rope, k_nope, k_rope, v


def mla_keys(k_nope, k_rope):
    k_rope = jnp.broadcast_to(k_rope, k_nope.shape[:-1] + (MLA_ROPE,))
    return jnp.concatenate([k_nope, k_rope], axis=-1)


def block_attention(q, k, v):
    b, nq, h, dq = q.shape
    nb = nq // Q_BLOCK
    scale = dq ** -0.5
    qb = jnp.moveaxis(q.reshape(b, nb, Q_BLOCK, h, dq), 1, 0)

    def one(qi):
        s = jnp.einsum('bqhd,bkhd->bhqk', qi, k).astype(jnp.float32) * scale
        p = jax.nn.softmax(s, axis=-1)
        return jnp.einsum('bhqk,bkhe->bqhe', p.astype(v.dtype), v)

    out = lax.map(one, qb)
    return jnp.moveaxis(out, 0, 1).reshape(b, nq, h * v.shape[-1])


def retention_chunked(q, k, v, log_gamma, s0, strict):
    b, h, n, dk = q.shape
    dv = v.shape[-1]
    cs = RET_CHUNK
    nc = n // cs
    qc = q.reshape(b, h, nc, cs, dk)
    kc = k.reshape(b, h, nc, cs, dk)
    vc = v.reshape(b, h, nc, cs, dv)
    idx = jnp.arange(cs, dtype=jnp.float32)
    diff = idx[:, None] - idx[None, :]
    mask = diff > 0 if strict else diff >= 0
    lg = log_gamma[:, None, None]
    dmat = jnp.where(mask[None], jnp.exp(lg * jnp.where(mask, diff, 0.0)[None]), 0.0)
    scores = jnp.einsum('bhnid,bhnjd->bhnij', qc, kc) * dmat[None, :, None]
    y_inner = jnp.einsum('bhnij,bhnje->bhnie', scores, vc)
    zeta = jnp.exp(log_gamma[:, None] * (cs - 1 - idx)[None, :])
    xi = jnp.exp(log_gamma[:, None] * (idx + 1.0)[None, :])
    kv = jnp.einsum('bhnjd,bhnje->bhnde', kc * zeta[None, :, None, :, None], vc)
    decay_chunk = jnp.exp(log_gamma * cs)[None, :, None, None]

    def step(s, kv_n):
        return decay_chunk * s + kv_n, s

    s_final, s_prev = lax.scan(step, s0, jnp.moveaxis(kv, 2, 0))
    s_prev = jnp.moveaxis(s_prev, 0, 2)
    y_cross = jnp.einsum('bhnid,bhnde->bhnie', qc * xi[None, :, None, :, None], s_prev)
    return (y_inner + y_cross).reshape(b, h, n, dv), s_final


def bidir_retention(q, k, v, lg_f, lg_b, s0_f, s0_b):
    y_f, s_f = retention_chunked(q, k, v, lg_f, s0_f, False)
    y_b, s_b = retention_chunked(jnp.flip(q, 2), jnp.flip(k, 2), jnp.flip(v, 2), lg_b, s0_b, True)
    return y_f + jnp.flip(y_b, 2), s_f, s_b


def retention_output(y, gate):
    mu = jnp.mean(y, axis=-1, keepdims=True)
    var = jnp.mean(jnp.square(y - mu), axis=-1, keepdims=True)
    y = (y - mu) * lax.rsqrt(var + GN_EPS)
    b, h, n, dv = y.shape
    y = jnp.swapaxes(y, 1, 2).reshape(b, n, h * dv)
    return (jax.nn.silu(gate.astype(jnp.float32)) * y).astype(gate.dtype)


def setup_inputs(seed: int = 0) -> dict:
    key = jax.random.key(seed)
    ks = jax.random.split(key, 24)
    f32 = jnp.float32

    def nrm(k, shape, scale):
        return jax.random.normal(k, shape, f32) * scale

    gam = 1.0 - 2.0 ** (-5.0 - jnp.arange(RET_HEADS, dtype=f32))
    decay_logit = jnp.log(gam) - jnp.log1p(-gam)
    return {
        "x": nrm(ks[0], (BATCH, SEQ, D_MODEL), 1.0),
        "c": nrm(ks[1], (BATCH, D_MODEL), 1.0),
        "ctx": nrm(ks[2], (BATCH, CTX_LEN, D_MODEL), 1.0),
        "c_ctx": nrm(ks[3], (D_MODEL,), 1.0),
        "ada_w": nrm(ks[4], (DEPTH, D_MODEL, N_MOD * D_MODEL), 0.5 * D_MODEL ** -0.5),
        "ada_b": nrm(ks[5], (DEPTH, N_MOD * D_MODEL), 0.02),
        "norm1_g": 1.0 + nrm(ks[6], (DEPTH, D_MODEL), 0.02),
        "ffn1_w_in": nrm(ks[7], (DEPTH, D_MODEL, 2 * D_FF), D_MODEL ** -0.5),
        "ffn1_w_out": nrm(ks[8], (DEPTH, D_FF, D_MODEL), D_FF ** -0.5),
        "norm2_g": 1.0 + nrm(ks[9], (DEPTH, D_MODEL), 0.02),
        "mix_w_in": nrm(ks[10], (DEPTH, D_MODEL, MIX_IN), D_MODEL ** -0.5),
        "ret_decay_fwd": decay_logit[None, :] + nrm(ks[11], (DEPTH, RET_HEADS), 0.05),
        "ret_decay_bwd": decay_logit[None, :] + nrm(ks[12], (DEPTH, RET_HEADS), 0.05),
        "mla_q_norm_g": 1.0 + nrm(ks[13], (DEPTH, MLA_Q_RANK), 0.02),
        "mla_w_uq": nrm(ks[14], (DEPTH, MLA_Q_RANK, MLA_HEADS * (MLA_NOPE + MLA_ROPE)), MLA_Q_RANK ** -0.5),
        "mla_kv_norm_g": 1.0 + nrm(ks[15], (DEPTH, MLA_KV_RANK), 0.02),
        "mla_w_ukv": nrm(ks[16], (DEPTH, MLA_KV_RANK, MLA_HEADS * (MLA_NOPE + MLA_V)), MLA_KV_RANK ** -0.5),
        "mix_w_out": nrm(ks[17], (DEPTH, MIX_OUT, D_MODEL), MIX_OUT ** -0.5),
        "norm3_g": 1.0 + nrm(ks[18], (DEPTH, D_MODEL), 0.02),
        "ffn2_w_in": nrm(ks[19], (DEPTH, D_MODEL, 2 * D_FF), D_MODEL ** -0.5),
        "ffn2_w_out": nrm(ks[20], (DEPTH, D_FF, D_MODEL), D_FF ** -0.5),
        "final_norm_g": 1.0 + nrm(ks[21], (D_MODEL,), 0.02),
    }


def reference(x, c, ctx, c_ctx, ada_w, ada_b, norm1_g, ffn1_w_in, ffn1_w_out, norm2_g,
              mix_w_in, ret_decay_fwd, ret_decay_bwd, mla_q_norm_g, mla_w_uq, mla_kv_norm_g,
              mla_w_ukv, mix_w_out, norm3_g, ffn2_w_in, ffn2_w_out, final_norm_g):
    b, n_lat, d = x.shape
    n_rows = n_lat // GRID_W
    pos_row = jnp.repeat(jnp.arange(n_rows), GRID_W)
    pos_col = jnp.tile(jnp.arange(GRID_W), n_rows)
    row_tab = rope_tables(pos_row, MLA_ROPE // 2, AXIAL_BASE)
    col_tab = rope_tables(pos_col, MLA_ROPE // 2, AXIAL_BASE)
    ret_tab = rope_tables(jnp.arange(n_lat), RET_DK, RET_ROPE_BASE)
    s_zero = jnp.zeros((b, RET_HEADS, RET_DK, RET_DV), jnp.float32)

    def heads(t):
        return jnp.swapaxes(t, 1, 2).astype(jnp.float32)

    for l in range(DEPTH):
        is_last = l == DEPTH - 1
        m_lat = (jax.nn.silu(c) @ ada_w[l] + ada_b[l]).reshape(b, N_MOD, 1, d)
        m_ctx = (jax.nn.silu(c_ctx)[None, :] @ ada_w[l] + ada_b[l]).reshape(1, N_MOD, 1, d)

        x = x + 0.5 * m_lat[:, 2] * swiglu(modulate(rms_norm(x, norm1_g[l]), m_lat[:, 0], m_lat[:, 1]),
                                           ffn1_w_in[l], ffn1_w_out[l])
        ctx = ctx + 0.5 * m_ctx[:, 2] * swiglu(modulate(rms_norm(ctx, norm1_g[l]), m_ctx[:, 0], m_ctx[:, 1]),
                                               ffn1_w_in[l], ffn1_w_out[l])

        hx = modulate(rms_norm(x, norm2_g[l]), m_lat[:, 3], m_lat[:, 4])
        hc = modulate(rms_norm(ctx, norm2_g[l]), m_ctx[:, 3], m_ctx[:, 4])
        rq, rk, rv, rg, qn, qr, kn, kr, v = project(
            hx, mix_w_in[l], mla_q_norm_g[l], mla_w_uq[l], mla_kv_norm_g[l], mla_w_ukv[l])
        crq, crk, crv, crg, cqn, cqr, ckn, ckr, cv = project(
            hc, mix_w_in[l], mla_q_norm_g[l], mla_w_uq[l], mla_kv_norm_g[l], mla_w_ukv[l])

        lg_f = jax.nn.log_sigmoid(ret_decay_fwd[l].astype(jnp.float32))
        lg_b = jax.nn.log_sigmoid(ret_decay_bwd[l].astype(jnp.float32))
        y_ctx, s_f, s_b = bidir_retention(heads(crq), heads(crk), heads(crv), lg_f, lg_b, s_zero, s_zero)
        rq = rotate(rq, *ret_tab)
        rk = rotate(rk, *ret_tab)
        y_lat, _, _ = bidir_retention(heads(rq), heads(rk), heads(rv), lg_f, lg_b, s_f, s_b)
        ret_out = retention_output(y_lat, rg)

        q_lat = jnp.concatenate([qn, axial_rope(qr, row_tab, col_tab)], axis=-1)
        k_lat = mla_keys(kn, axial_rope(kr, row_tab, col_tab))
        k_ctx = mla_keys(ckn, ckr)
        k_all = jnp.concatenate([k_lat, k_ctx], axis=1)
        v_all = jnp.concatenate([v, cv], axis=1)
        mla_out = block_attention(q_lat, k_all, v_all)

        mix = jnp.concatenate([ret_out.astype(x.dtype), mla_out.astype(x.dtype)], axis=-1) @ mix_w_out[l]
        x = x + m_lat[:, 5] * mix
        if not is_last:
            ctx_ret = retention_output(y_ctx, crg)
            ctx_mla = block_attention(jnp.concatenate([cqn, cqr], axis=-1), k_ctx, cv)
            ctx_mix = jnp.concatenate([ctx_ret.astype(ctx.dtype), ctx_mla.astype(ctx.dtype)], axis=-1) @ mix_w_out[l]
            ctx = ctx + m_ctx[:, 5] * ctx_mix

        x = x + 0.5 * m_lat[:, 8] * swiglu(modulate(rms_norm(x, norm3_g[l]), m_lat[:, 6], m_lat[:, 7]),
                                           ffn2_w_in[l], ffn2_w_out[l])
        if not is_last:
            ctx = ctx + 0.5 * m_ctx[:, 8] * swiglu(modulate(rms_norm(ctx, norm3_g[l]), m_ctx[:, 6], m_ctx[:, 7]),
                                                   ffn2_w_in[l], ffn2_w_out[l])

    return rms_norm(x, final_norm_g)
```

```cpp
#include <hip/hip_runtime.h>
#include <hip/hip_cooperative_groups.h>
#include <cstdio>
#include <cstdint>
namespace cg = cooperative_groups;

typedef unsigned short bf16_t;
typedef short bf16x8 __attribute__((ext_vector_type(8)));
typedef short s16x4 __attribute__((ext_vector_type(4)));
typedef float f32x4 __attribute__((ext_vector_type(4)));
typedef float f32x2 __attribute__((ext_vector_type(2)));
typedef float f32x16 __attribute__((ext_vector_type(16)));
typedef unsigned u32x4 __attribute__((ext_vector_type(4)));
typedef unsigned u32x2 __attribute__((ext_vector_type(2)));
#define LAS __attribute__((address_space(3)))

constexpr int NLAT = 16384, MALL = 16896, DM = 2048, DFF = 5632, PROJ_LD = 3904, SKV = 8448;
constexpr int C_RQ = 0, C_RK = 512, C_RV = 1024, C_RG = 2048, C_CQ = 3072, C_CKV = 3584, C_KR = 3840;
constexpr int LDH = 2112;
constexpr int LDS_BYTES = 131072 + 16;
constexpr float LOG2E = 1.4426950408889634f;

constexpr size_t OFF_MOD = 0;
constexpr size_t OFF_RCOS = OFF_MOD + 221184;
constexpr size_t OFF_RSIN = OFF_RCOS + 1048576;
constexpr size_t OFF_ACOS = OFF_RSIN + 1048576;
constexpr size_t OFF_ASIN = OFF_ACOS + 8192;
constexpr size_t OFF_WF1IN = OFF_ASIN + 8192;
constexpr size_t OFF_WF1OUT = OFF_WF1IN + (size_t)11264 * LDH * 2;
constexpr size_t OFF_STATES = OFF_WF1IN;
constexpr size_t OFF_WF2IN = OFF_WF1OUT + 23068672;
constexpr size_t OFF_WF2OUT = OFF_WF2IN + (size_t)11264 * LDH * 2;
constexpr size_t OFF_WMIXIN = OFF_WF2OUT + 23068672;
constexpr size_t OFF_WUQ = OFF_WMIXIN + (size_t)4096 * LDH * 2;
constexpr size_t OFF_WUKV = OFF_WUQ + 1572864;
constexpr size_t OFF_WMIXOUT = OFF_WUKV + 1048576;
constexpr size_t OFF_H = OFF_WMIXOUT + (size_t)2048 * LDH * 2;
constexpr size_t OFF_BIG = OFF_H + (size_t)16896 * LDH * 2;
constexpr size_t OFF_XC = OFF_BIG + 209715200;
constexpr size_t OFF_ACT = OFF_BIG;
constexpr size_t OFF_PROJ = OFF_BIG;
constexpr size_t OFF_CQN = OFF_PROJ + 131923968;
constexpr size_t OFF_CKVN = OFF_CQN + 16777216;
constexpr size_t OFF_Q = OFF_CKVN + 8650752;
constexpr size_t OFF_K = OFF_Q + 50331648;
constexpr size_t OFF_V = OFF_K + 51904512;
constexpr size_t OFF_BAR = OFF_V + 34603008;
constexpr size_t OFF_XB = OFF_BAR + 16384;
constexpr size_t WS_END = OFF_XB + 67108864;

struct Params {
    const float *x, *c, *ctx, *c_ctx, *ada_w, *ada_b, *n1g, *f1in, *f1out, *n2g, *mixin, *rdf, *rdb, *qng, *wuq, *kvng, *wukv, *mixout, *n3g, *f2in, *f2out, *fng;
    float* out;
    unsigned char* ws;
};

__device__ __forceinline__ unsigned cvt_pk_bf16(float lo, float hi) { unsigned r; asm volatile("v_cvt_pk_bf16_f32 %0, %1, %2" : "=v"(r) : "v"(lo), "v"(hi)); return r; }
__device__ __forceinline__ float bflo(unsigned w) { return __uint_as_float(w << 16); }
__device__ __forceinline__ float bfhi(unsigned w) { return __uint_as_float(w & 0xffff0000u); }
__device__ __forceinline__ float bf2f(bf16_t b) { return __uint_as_float(((unsigned)b) << 16); }
__device__ __forceinline__ bf16_t f2bf(float f) { return (bf16_t)(cvt_pk_bf16(f, 0.f) & 0xffffu); }
__device__ __forceinline__ float silu_f(float g) { return g * __builtin_amdgcn_rcpf(1.0f + __expf(-g)); }
__device__ __forceinline__ int lane_id_v() { int l; asm volatile("v_mbcnt_lo_u32_b32 %0, -1, 0\n\tv_mbcnt_hi_u32_b32 %0, -1, %0" : "=v"(l)); return l; }
#define TIDX(wv) ((wv) * 64 + lane_id_v())
__device__ __forceinline__ float wave_sum(float v) {
#pragma unroll
    for (int o = 32; o >= 1; o >>= 1) v += __shfl_xor(v, o);
    return v;
}

namespace pg8 {
constexpr int BM = 256, BK = 64, HALF = 128, HTB = HALF * BK * 2, STAGE_BYTES = 8 * HTB, NXCD = 8, WGM = 8;
__host__ __device__ __forceinline__ int lds_byte(int r, int c) { const int st = (r >> 4) * 2 + (c >> 5), rr = r & 15, cc = c & 31, ob = rr * 64 + cc * 2; return st * 1024 + (ob ^ (((ob >> 9) & 1) << 5)); }
__host__ __device__ __forceinline__ void stage_rc(int b, int& R, int& C) { const int st = b / 1024, sb = b % 1024, swz = sb ^ (((sb >> 9) & 1) << 5); R = (st >> 1) * 16 + swz / 64; C = (st & 1) * 32 + (swz % 64) / 2; }
__host__ __device__ __forceinline__ int perm32(int rho) { const int n = rho >> 4, i = rho & 15; return 8 * (i >> 2) + 4 * n + (i & 3); }
struct Unit { int pm, pn; };
struct Gemm { const bf16_t* A; const bf16_t* Bt; int M, N, K, lda, ldb; };
struct StaticOrder {
    int nM, nN, nwg, G, c;
    __device__ void init(int M, int N, int G_, int c_) { nM = M / BM; nN = N / BM; nwg = nM * nN; G = G_; c = c_; }
    __device__ bool next(int i, Unit& u) const {
        const long L = (long)i * G + c; if (L >= nwg) return false;
        int wgid = (int)L; { const int q = nwg / NXCD, r = nwg % NXCD, xcd = wgid % NXCD, off = wgid / NXCD; wgid = (xcd < r ? xcd * (q + 1) : r * (q + 1) + (xcd - r) * q) + off; }
        const int nig = WGM * nN, gid = wgid / nig, fm = gid * WGM, gsz = (nM - fm) < WGM ? (nM - fm) : WGM;
        u.pm = fm + ((wgid % nig) % gsz); u.pn = (wgid % nig) / gsz; return true;
    }
    __device__ __forceinline__ size_t a_off(const Unit& u, size_t tA) const { return (size_t)u.pm * tA; }
    __device__ __forceinline__ size_t b_off(const Unit& u, size_t tB) const { return (size_t)u.pn * tB; }
};
template <int NP> struct SplitKOrder : StaticOrder {
    size_t ksb;
    __device__ __forceinline__ size_t a_off(const Unit& u, size_t tA) const { return (size_t)(u.pm % NP) * tA + (size_t)(u.pm / NP) * ksb; }
    __device__ __forceinline__ size_t b_off(const Unit& u, size_t tB) const { return (size_t)u.pn * tB + (size_t)(u.pm / NP) * ksb; }
};
template <class Epi, class Sched>
__device__ __forceinline__ void gemm_phase(LAS unsigned char* lds, const Gemm g, const Sched& S, const Epi& E, int wv) {
    const int lane = lane_id_v(), wid = wv, tid = wid * 64 + lane, wr = wid >> 2, wc = wid & 3, fr = lane & 15, fq = lane >> 4;
    const int K = g.K, nt = K / BK;
    unsigned voffA[2], voffB[2];
#pragma unroll
    for (int i = 0; i < 2; ++i) { int R, C; stage_rc(tid * 16 + i * 8192, R, C); const int Rb = Epi::PERM ? ((R & ~31) + perm32(R & 31)) : R;
        voffA[i] = (unsigned)(R * g.lda + C) * 2u; voffB[i] = (unsigned)(Rb * g.ldb + C) * 2u; }
    const size_t kstep = (size_t)(BK * 2);
    const size_t hA = (size_t)HALF * g.lda * 2, hB = (size_t)HALF * g.ldb * 2;
    const size_t tA = 2 * hA, tB = 2 * hB;
    const unsigned ldsw = (unsigned)wid * 1024u;
    const int aoff = lds_byte(wr * 64 + fr, fq * 8), boff = lds_byte(wc * 32 + fr, fq * 8);
#define PG8_SA(b, h) (((b) * 2 + (h)) * HTB)
#define PG8_SB(b, h) ((4 + (b) * 2 + (h)) * HTB)
#define PG8_STAGE(bufoff, gbase, voff) do { _Pragma("unroll") for (int _i = 0; _i < 2; ++_i) \
        __builtin_amdgcn_global_load_lds((const unsigned*)((const char*)(gbase) + (voff)[_i]), (LAS unsigned*)(lds + (bufoff) + ldsw + _i * 8192), 16, 0, 0); } while (0)
#define PG8_LDA(dst, b, h) do { _Pragma("unroll") for (int m = 0; m < 4; ++m) _Pragma("unroll") for (int k = 0; k < 2; ++k) dst[m][k] = *(const LAS bf16x8*)(lds + PG8_SA(b, h) + aoff + m * 2048 + k * 1024); } while (0)
#define PG8_LDB(dst, b, h) do { _Pragma("unroll") for (int n = 0; n < 2; ++n) _Pragma("unroll") for (int k = 0; k < 2; ++k) dst[n][k] = *(const LAS bf16x8*)(lds + PG8_SB(b, h) + boff + n * 2048 + k * 1024); } while (0)
#define PG8_MMA(ai, bj, At, Bt) do { __builtin_amdgcn_s_setprio(1); _Pragma("unroll") for (int m = 0; m < 4; ++m) _Pragma("unroll") for (int n = 0; n < 2; ++n) _Pragma("unroll") for (int k = 0; k < 2; ++k) \
        acc[ai][bj][m][n] = __builtin_amdgcn_mfma_f32_16x16x32_bf16(Bt[n][k], At[m][k], acc[ai][bj][m][n], 0, 0, 0); __builtin_amdgcn_s_setprio(0); } while (0)
#define PG8_WAIT_V(n) asm volatile("s_waitcnt vmcnt(" #n ")" ::: "memory")
#define PG8_WAIT_L(n) asm volatile("s_waitcnt lgkmcnt(" #n ")" ::: "memory")
#define PG8_BAR __builtin_amdgcn_s_barrier()
#define PG8_SCHED __builtin_amdgcn_sched_barrier(0)
    Unit cur, nxt; int ui = 0;
    if (!S.next(0, cur)) return;
    f32x4 acc[2][2][4][2];
#pragma unroll
    for (int a = 0; a < 2; ++a)
#pragma unroll
        for (int b = 0; b < 2; ++b)
#pragma unroll
            for (int m = 0; m < 4; ++m)
#pragma unroll
                for (int n = 0; n < 2; ++n) acc[a][b][m][n] = (f32x4){0.f, 0.f, 0.f, 0.f};
    bf16x8 At[4][2], B0[2][2], B1[2][2];
    const char* cA = (const char*)g.A + S.a_off(cur, tA); const char* cB = (const char*)g.Bt + S.b_off(cur, tB);
    PG8_STAGE(PG8_SB(0, 0), cB, voffB); PG8_STAGE(PG8_SA(0, 0), cA, voffA); PG8_STAGE(PG8_SB(0, 1), cB + hB, voffB); PG8_STAGE(PG8_SA(0, 1), cA + hA, voffA);
    if (wr == 1) PG8_BAR;
    PG8_WAIT_V(4); PG8_BAR;
    PG8_STAGE(PG8_SB(1, 0), cB + kstep, voffB); PG8_STAGE(PG8_SA(1, 0), cA + kstep, voffA); PG8_STAGE(PG8_SB(1, 1), cB + hB + kstep, voffB);
    PG8_WAIT_V(6); PG8_BAR;
    for (;;) {
        const bool has_next = S.next(ui + 1, nxt);
        const char* nA = has_next ? (const char*)g.A + S.a_off(nxt, tA) : cA; const char* nB = has_next ? (const char*)g.Bt + S.b_off(nxt, tB) : cB;
        for (int t = 0; t < nt; t += 2) {
            const bool last = (t == nt - 2);
            const char* a1 = cA + (size_t)(t + 1) * kstep;
            const char* a2 = last ? nA : cA + (size_t)(t + 2) * kstep; const char* b2 = last ? nB : cB + (size_t)(t + 2) * kstep;
            const char* a3 = a2 + kstep; const char* b3 = b2 + kstep;
            PG8_LDB(B0, 0, 0); PG8_SCHED; PG8_LDA(At, 0, 0); PG8_STAGE(PG8_SA(1, 1), a1 + hA, voffA);
            PG8_WAIT_L(8); PG8_BAR; PG8_WAIT_L(0); PG8_MMA(0, 0, At, B0); PG8_BAR; PG8_SCHED;
            PG8_LDB(B1, 0, 1); PG8_STAGE(PG8_SB(0, 0), b2, voffB);
            PG8_BAR; PG8_WAIT_L(0); PG8_MMA(0, 1, At, B1); PG8_BAR;
            PG8_LDA(At, 0, 1); PG8_STAGE(PG8_SA(0, 0), a2, voffA);
            PG8_BAR; PG8_WAIT_L(0); PG8_MMA(1, 0, At, B0); PG8_BAR; PG8_SCHED;
            PG8_STAGE(PG8_SB(0, 1), b2 + hB, voffB);
            PG8_WAIT_V(6); PG8_BAR; PG8_MMA(1, 1, At, B1); PG8_BAR;
            PG8_LDB(B0, 1, 0); PG8_SCHED; PG8_LDA(At, 1, 0); PG8_STAGE(PG8_SA(0, 1), a2 + hA, voffA);
            PG8_WAIT_L(8); PG8_BAR; PG8_WAIT_L(0); PG8_MMA(0, 0, At, B0); PG8_BAR; PG8_SCHED;
            PG8_LDB(B1, 1, 1); PG8_STAGE(PG8_SB(1, 0), b3, voffB);
            PG8_BAR; PG8_WAIT_L(0); PG8_MMA(0, 1, At, B1); PG8_BAR;
            PG8_LDA(At, 1, 1); PG8_STAGE(PG8_SA(1, 0), a3, voffA);
            PG8_BAR; PG8_WAIT_L(0); PG8_MMA(1, 0, At, B0); PG8_BAR; PG8_SCHED;
            PG8_STAGE(PG8_SB(1, 1), b3 + hB, voffB);
            PG8_WAIT_V(6); PG8_BAR; PG8_MMA(1, 1, At, B1); PG8_BAR;
        }
        E(acc, cur, wr, wc, fr, fq);
        if (!has_next) break;
#pragma unroll
        for (int a = 0; a < 2; ++a)
#pragma unroll
            for (int b = 0; b < 2; ++b)
#pragma unroll
                for (int m = 0; m < 4; ++m)
#pragma unroll
                    for (int n = 0; n < 2; ++n) acc[a][b][m][n] = (f32x4){0.f, 0.f, 0.f, 0.f};
        cur = nxt; cA = nA; cB = nB; ++ui;
    }
    PG8_WAIT_V(0);
    if (wr == 0) PG8_BAR;
    PG8_BAR;
#undef PG8_SA
#undef PG8_SB
#undef PG8_STAGE
#undef PG8_LDA
#undef PG8_LDB
#undef PG8_MMA
#undef PG8_WAIT_V
#undef PG8_WAIT_L
#undef PG8_BAR
#undef PG8_SCHED
}
}

typedef f32x4 AccT[2][2][4][2];
struct EpiSwiglu {
    static constexpr bool PERM = true;
    bf16_t* O;
    __device__ __forceinline__ void operator()(const AccT& acc, const pg8::Unit& u, int wr, int wc, int fr, int fq) const {
        const int row0 = u.pm * 256 + wr * 64 + fr, col0 = u.pn * 128 + wc * 32 + 8 * fq;
#pragma unroll
        for (int ai = 0; ai < 2; ++ai)
#pragma unroll
            for (int m = 0; m < 4; ++m) {
                bf16_t* rowp = O + (size_t)(row0 + ai * 128 + m * 16) * DFF + col0;
                const f32x4 g0 = acc[ai][0][m][0], g1 = acc[ai][0][m][1], u0 = acc[ai][1][m][0], u1 = acc[ai][1][m][1];
                u32x4 w;
                w.x = cvt_pk_bf16(silu_f(g0[0]) * u0[0], silu_f(g0[1]) * u0[1]); w.y = cvt_pk_bf16(silu_f(g0[2]) * u0[2], silu_f(g0[3]) * u0[3]);
                w.z = cvt_pk_bf16(silu_f(g1[0]) * u1[0], silu_f(g1[1]) * u1[1]); w.w = cvt_pk_bf16(silu_f(g1[2]) * u1[2], silu_f(g1[3]) * u1[3]);
                *(u32x4*)rowp = w;
            }
    }
};
struct EpiResid {
    static constexpr bool PERM = false;
    const float* baseLat; const float* baseCtx; float* outLat; float* outCtx; const float* mod; int gidx; float coef;
    __device__ __forceinline__ void operator()(const AccT& acc, const pg8::Unit& u, int wr, int wc, int fr, int fq) const {
        const bool lat = u.pm < 64; const int grp = lat ? (u.pm >> 5) : 2;
        const float* base = lat ? baseLat : baseCtx; float* out = lat ? outLat : outCtx;
        const int row0 = (lat ? u.pm : u.pm - 64) * 256 + wr * 64 + fr, col0 = u.pn * 256 + wc * 32 + 4 * fq;
        const float* gp = mod + (size_t)(grp * 9 + gidx) * DM + col0;
        f32x4 gv[2][2];
#pragma unroll
        for (int bj = 0; bj < 2; ++bj)
#pragma unroll
            for (int n = 0; n < 2; ++n) gv[bj][n] = *(const f32x4*)(gp + bj * 128 + n * 16) * coef;
#pragma unroll
        for (int ai = 0; ai < 2; ++ai)
#pragma unroll
            for (int m = 0; m < 4; ++m) {
                const size_t off = (size_t)(row0 + ai * 128 + m * 16) * DM + col0;
#pragma unroll
                for (int bj = 0; bj < 2; ++bj)
#pragma unroll
                    for (int n = 0; n < 2; ++n) {
                        const f32x4 b = *(const f32x4*)(base + off + bj * 128 + n * 16);
                        *(f32x4*)(out + off + bj * 128 + n * 16) = b + gv[bj][n] * acc[ai][bj][m][n];
                    }
            }
    }
};
template <bool BASE_F32, bool OUT_F32> struct EpiResidB {
    static constexpr bool PERM = true;
    const float* basef; const bf16_t* baseb; float* outf; bf16_t* outb; const float* mod; int gidx; float coef;
    __device__ __forceinline__ void operator()(const AccT& acc, const pg8::Unit& u, int wr, int wc, int fr, int fq) const {
        const int grp = u.pm >> 5;
        const int row0 = u.pm * 256 + wr * 64 + fr, col0 = u.pn * 256 + wc * 32 + 8 * fq;
        const float* gp = mod + (size_t)(grp * 9 + gidx) * DM + col0;
        f32x4 gv[2][2];
#pragma unroll
        for (int bj = 0; bj < 2; ++bj)
#pragma unroll
            for (int n = 0; n < 2; ++n) gv[bj][n] = *(const f32x4*)(gp + bj * 128 + n * 4) * coef;
#pragma unroll
        for (int ai = 0; ai < 2; ++ai)
#pragma unroll
            for (int m = 0; m < 4; ++m) {
                const size_t off = (size_t)(row0 + ai * 128 + m * 16) * DM + col0;
#pragma unroll
                for (int bj = 0; bj < 2; ++bj) {
                    f32x4 b0, b1;
                    if (BASE_F32) { b0 = *(const f32x4*)(basef + off + bj * 128); b1 = *(const f32x4*)(basef + off + bj * 128 + 4); }
                    else { const u32x4 w = *(const u32x4*)(baseb + off + bj * 128); b0 = (f32x4){bflo(w.x), bfhi(w.x), bflo(w.y), bfhi(w.y)}; b1 = (f32x4){bflo(w.z), bfhi(w.z), bflo(w.w), bfhi(w.w)}; }
                    const f32x4 x0 = b0 + gv[bj][0] * acc[ai][bj][m][0], x1 = b1 + gv[bj][1] * acc[ai][bj][m][1];
                    if (OUT_F32) { *(f32x4*)(outf + off + bj * 128) = x0; *(f32x4*)(outf + off + bj * 128 + 4) = x1; }
                    else { u32x4 w; w.x = cvt_pk_bf16(x0[0], x0[1]); w.y = cvt_pk_bf16(x0[2], x0[3]); w.z = cvt_pk_bf16(x1[0], x1[1]); w.w = cvt_pk_bf16(x1[2], x1[3]); *(u32x4*)(outb + off + bj * 128) = w; }
                }
            }
    }
};
struct EpiKrPart {
    static constexpr bool PERM = false;
    float* part;
    __device__ __forceinline__ void operator()(const AccT& acc, const pg8::Unit& u, int wr, int wc, int fr, int fq) const {
        if (wc >= 2) return;
        const int ks = u.pm / 66, panel = u.pm % 66;
        const int row0 = panel * 256 + wr * 64 + fr, col0 = wc * 32 + 4 * fq;
#pragma unroll
        for (int ai = 0; ai < 2; ++ai)
#pragma unroll
            for (int m = 0; m < 4; ++m) {
                float* rowp = part + ((size_t)ks * MALL + row0 + ai * 128 + m * 16) * 64 + col0;
                *(f32x4*)(rowp) = acc[ai][0][m][0]; *(f32x4*)(rowp + 16) = acc[ai][0][m][1];
            }
    }
};
struct EpiPartial {
    static constexpr bool PERM = false;
    float* part;
    __device__ __forceinline__ void operator()(const AccT& acc, const pg8::Unit& u, int wr, int wc, int fr, int fq) const {
        const int row0 = u.pm * 256 + wr * 64 + fr, col0 = u.pn * 256 + wc * 32 + 4 * fq;
#pragma unroll
        for (int ai = 0; ai < 2; ++ai)
#pragma unroll
            for (int m = 0; m < 4; ++m) {
                float* rowp = part + (size_t)(row0 + ai * 128 + m * 16) * DM + col0;
#pragma unroll
                for (int bj = 0; bj < 2; ++bj)
#pragma unroll
                    for (int n = 0; n < 2; ++n) *(f32x4*)(rowp + bj * 128 + n * 16) = acc[ai][bj][m][n];
            }
    }
};
struct EpiProj {
    static constexpr bool PERM = true;
    bf16_t* O; const float* rcos; const float* rsin;
    __device__ __forceinline__ void operator()(const AccT& acc, const pg8::Unit& u, int wr, int wc, int fr, int fq) const {
        const int row0 = u.pm * 256 + wr * 64 + fr, col0 = u.pn * 256 + wc * 32 + 8 * fq;
        if (u.pn < 4) {
            const float sc = (u.pn >= 2) ? 0.125f : 1.0f;
            const bool lat = u.pm < 64;
            const int f = (wc & 1) * 16 + 4 * fq;
#pragma unroll
            for (int ai = 0; ai < 2; ++ai)
#pragma unroll
                for (int m = 0; m < 4; ++m) {
                    const int r = row0 + ai * 128 + m * 16;
                    f32x4 cs = {1.f, 1.f, 1.f, 1.f}, sn = {0.f, 0.f, 0.f, 0.f};
                    if (lat) { const int t = r & 8191; cs = *(const f32x4*)(rcos + (size_t)t * 32 + f); sn = *(const f32x4*)(rsin + (size_t)t * 32 + f); }
                    bf16_t* rowp = O + (size_t)r * PROJ_LD;
#pragma unroll
                    for (int bj = 0; bj < 2; ++bj) {
                        const int head0 = ((u.pn * 256 + bj * 128 + wc * 32) >> 6) << 6;
                        const f32x4 x1 = acc[ai][bj][m][0], x2 = acc[ai][bj][m][1];
                        const f32x4 o1 = (x1 * cs - x2 * sn) * sc, o2 = (x2 * cs + x1 * sn) * sc;
                        u32x2 a, b; a.x = cvt_pk_bf16(o1[0], o1[1]); a.y = cvt_pk_bf16(o1[2], o1[3]); b.x = cvt_pk_bf16(o2[0], o2[1]); b.y = cvt_pk_bf16(o2[2], o2[3]);
                        *(u32x2*)(rowp + head0 + f) = a; *(u32x2*)(rowp + head0 + 32 + f) = b;
                    }
                }
            return;
        }
#pragma unroll
        for (int ai = 0; ai < 2; ++ai)
#pragma unroll
            for (int m = 0; m < 4; ++m) {
                bf16_t* rowp = O + (size_t)(row0 + ai * 128 + m * 16) * PROJ_LD;
#pragma unroll
                for (int bj = 0; bj < 2; ++bj) {
                    const int c = col0 + bj * 128;
                    if (c < PROJ_LD) {
                        const f32x4 v0 = acc[ai][bj][m][0], v1 = acc[ai][bj][m][1];
                        u32x4 w; w.x = cvt_pk_bf16(v0[0], v0[1]); w.y = cvt_pk_bf16(v0[2], v0[3]); w.z = cvt_pk_bf16(v1[0], v1[1]); w.w = cvt_pk_bf16(v1[2], v1[3]);
                        *(u32x4*)(rowp + c) = w;
                    }
                }
            }
    }
};
struct EpiQ {
    static constexpr bool PERM = false;
    bf16_t* Q; const float* axc; const float* axs;
    __device__ __forceinline__ void operator()(const AccT& acc, const pg8::Unit& u, int wr, int wc, int fr, int fq) const {
        const int row0 = u.pm * 256 + wr * 64 + fr;
#pragma unroll
        for (int bj = 0; bj < 2; ++bj) {
            const int grp32 = 8 * u.pn + 4 * bj + wc; const int w6 = grp32 % 6; const bool rope = w6 >= 4; const int part = w6 - 4;
            const int col = grp32 * 32 + 4 * fq;
#pragma unroll
            for (int ai = 0; ai < 2; ++ai)
#pragma unroll
                for (int m = 0; m < 4; ++m) {
                    const int r = row0 + ai * 128 + m * 16; const int t = r & 8191; const int pos = (part == 0) ? (t >> 6) : (t & 63);
                    f32x4 x1 = acc[ai][bj][m][0], x2 = acc[ai][bj][m][1];
                    if (rope) {
                        const f32x4 cs = *(const f32x4*)(axc + pos * 16 + 4 * fq), sn = *(const f32x4*)(axs + pos * 16 + 4 * fq);
                        const f32x4 o1 = x1 * cs - x2 * sn, o2 = x2 * cs + x1 * sn; x1 = o1; x2 = o2;
                    }
                    bf16_t* rowp = Q + (size_t)r * 1536 + col;
                    u32x2 a, b; a.x = cvt_pk_bf16(x1[0], x1[1]); a.y = cvt_pk_bf16(x1[2], x1[3]); b.x = cvt_pk_bf16(x2[0], x2[1]); b.y = cvt_pk_bf16(x2[2], x2[3]);
                    *(u32x2*)rowp = a; *(u32x2*)(rowp + 16) = b;
                }
        }
    }
};
struct EpiKV {
    static constexpr bool PERM = true;
    bf16_t* Kd; bf16_t* Vd; int pm0;
    __device__ __forceinline__ void operator()(const AccT& acc, const pg8::Unit& u, int wr, int wc, int fr, int fq) const {
        const int pmg = u.pm + pm0; const bool lat = pmg < 64; const int b = lat ? (pmg >> 5) : (pmg - 64); const int key0 = lat ? (pmg & 31) * 256 : 8192;
        const int e0 = wc * 32 + 8 * fq; const size_t bh = (size_t)(b * 8 + u.pn) * SKV;
#pragma unroll
        for (int ai = 0; ai < 2; ++ai)
#pragma unroll
            for (int m = 0; m < 4; ++m) {
                const size_t key = bh + key0 + ai * 128 + wr * 64 + m * 16 + fr;
                { const f32x4 v0 = acc[ai][0][m][0], v1 = acc[ai][0][m][1]; u32x4 w; w.x = cvt_pk_bf16(v0[0], v0[1]); w.y = cvt_pk_bf16(v0[2], v0[3]); w.z = cvt_pk_bf16(v1[0], v1[1]); w.w = cvt_pk_bf16(v1[2], v1[3]);
                  *(u32x4*)(Kd + key * 192 + e0) = w; }
                { const f32x4 v0 = acc[ai][1][m][0], v1 = acc[ai][1][m][1]; u32x4 w; w.x = cvt_pk_bf16(v0[0], v0[1]); w.y = cvt_pk_bf16(v0[2], v0[3]); w.z = cvt_pk_bf16(v1[0], v1[1]); w.w = cvt_pk_bf16(v1[2], v1[3]);
                  *(u32x4*)(Vd + key * 128 + e0) = w; }
            }
    }
};

template <class Epi>
__device__ __forceinline__ void run_gemm(unsigned char* shm, const bf16_t* A, const bf16_t* Bt, int M, int N, int K, const Epi& E, int wv, int cblk = -1, int lda = 0, int ldb = 0) {
    __syncthreads();
    pg8::Gemm g; g.A = A; g.Bt = Bt; g.M = M; g.N = N; g.K = K; g.lda = lda ? lda : K; g.ldb = ldb ? ldb : K;
    pg8::StaticOrder S; S.init(M, N, (int)gridDim.x, cblk < 0 ? (int)blockIdx.x : cblk);
    pg8::gemm_phase<Epi, pg8::StaticOrder>((LAS unsigned char*)shm, g, S, E, wv);
    __syncthreads();
}
template <class Epi, int NP>
__device__ __forceinline__ void run_gemm_splitk(unsigned char* shm, const bf16_t* A, const bf16_t* Bt, int N, int K, int KS, const Epi& E, int wv, int ld = 0, int cblk = -1) {
    __syncthreads();
    pg8::Gemm g; g.A = A; g.Bt = Bt; g.M = NP * 256 * KS; g.N = N; g.K = K / KS; g.lda = ld ? ld : K; g.ldb = ld ? ld : K;
    pg8::SplitKOrder<NP> S; S.init(g.M, N, (int)gridDim.x, cblk < 0 ? (int)blockIdx.x : cblk); S.ksb = (size_t)(K / KS) * 2;
    pg8::gemm_phase<Epi, pg8::SplitKOrder<NP>>((LAS unsigned char*)shm, g, S, E, wv);
    __syncthreads();
}

namespace att {
constexpr int QBLK = 32, KVBLK = 64, LDQ = 1536, LDO = LDH;
constexpr float SCALE = 0.07216878364870323f;
constexpr float THR = 8.f;
constexpr int SHM_V = 64 * 128 * 2, SHM_K = 64 * 192 * 2;
#ifndef ATT_NQR
#define ATT_NQR 12
#endif
constexpr int NQR = ATT_NQR;
#define KSWZ(row, colB) ((row) * 384 + ((colB) ^ ((((row) >> 1) & 7) << 4)))
#define SBAR() __builtin_amdgcn_sched_barrier(0)
__device__ __forceinline__ int crow(int r, int hi) { return (r & 3) + 8 * (r >> 2) + 4 * hi; }
__device__ __forceinline__ void partialSM(f32x16& p0, f32x16& p1, float& m_reg, float& mn, float& alpha) {
    constexpr float C = SCALE * 1.4426950408889634f;
    float pmax = p0[0];
#pragma unroll
    for (int r = 1; r < 16; ++r) pmax = fmaxf(pmax, p0[r]);
#pragma unroll
    for (int r = 0; r < 16; ++r) pmax = fmaxf(pmax, p1[r]);
    { auto rr = __builtin_amdgcn_permlane32_swap(__float_as_uint(pmax), __float_as_uint(pmax), false, false);
      pmax = fmaxf(__uint_as_float(rr[0]), __uint_as_float(rr[1])); }
    if (__builtin_expect(__all(pmax - m_reg <= THR / SCALE), 1)) { mn = m_reg; alpha = 1.f; }
    else { mn = fmaxf(m_reg, pmax); alpha = __builtin_amdgcn_exp2f((m_reg - mn) * C); m_reg = mn; }
    const float mnC = -mn * C;
#pragma unroll
    for (int r = 0; r < 16; ++r) p0[r] = fmaf(p0[r], C, mnC);
#pragma unroll
    for (int r = 0; r < 16; ++r) p1[r] = fmaf(p1[r], C, mnC);
#pragma unroll
    for (int r = 0; r < 16; ++r) p0[r] = __builtin_amdgcn_exp2f(p0[r]);
}
__device__ __forceinline__ void finishSM(f32x16& p0, f32x16& p1, float alpha, float& l_reg, bf16x8& pa0, bf16x8& pa1, bf16x8& pa2, bf16x8& pa3) {
#pragma unroll
    for (int r = 0; r < 16; ++r) p1[r] = __builtin_amdgcn_exp2f(p1[r]);
    float ps = 0;
#pragma unroll
    for (int r = 0; r < 16; ++r) ps += p0[r];
#pragma unroll
    for (int r = 0; r < 16; ++r) ps += p1[r];
    { auto rr = __builtin_amdgcn_permlane32_swap(__float_as_uint(ps), __float_as_uint(ps), false, false);
      ps = __uint_as_float(rr[0]) + __uint_as_float(rr[1]); }
    l_reg = l_reg * alpha + ps;
#define PK4(P, BASE, OUT) do { unsigned a0 = cvt_pk_bf16(P[BASE + 0], P[BASE + 1]), a1 = cvt_pk_bf16(P[BASE + 2], P[BASE + 3]);   \
    unsigned b0 = cvt_pk_bf16(P[BASE + 4], P[BASE + 5]), b1 = cvt_pk_bf16(P[BASE + 6], P[BASE + 7]);                              \
    auto r0 = __builtin_amdgcn_permlane32_swap(a0, b0, false, false); auto r1 = __builtin_amdgcn_permlane32_swap(a1, b1, false, false); \
    u32x4 w = {r0[0], r1[0], r0[1], r1[1]}; OUT = *reinterpret_cast<bf16x8*>(&w); } while (0)
    PK4(p0, 0, pa0); PK4(p0, 8, pa1); PK4(p1, 0, pa2); PK4(p1, 8, pa3);
#undef PK4
}
__device__ __forceinline__ void qkt(f32x16& p0, f32x16& p1, const char* Ks, const bf16x8* qr, const char* qro, int r32, int hi) {
    p0 = f32x16{}; p1 = f32x16{};
#pragma unroll
    for (int d0 = 0; d0 < 12; ++d0) { const int cb = (d0 * 16 + hi * 8) * 2;
        const bf16x8 b0 = *reinterpret_cast<const bf16x8*>(Ks + KSWZ(r32, cb));
        const bf16x8 b1 = *reinterpret_cast<const bf16x8*>(Ks + KSWZ(32 + r32, cb));
        const bf16x8 qv = d0 < NQR ? qr[d0 < NQR ? d0 : 0] : *reinterpret_cast<const bf16x8*>(qro + (d0 - NQR) * 1024);
        p0 = __builtin_amdgcn_mfma_f32_32x32x16_bf16(b0, qv, p0, 0, 0, 0);
        p1 = __builtin_amdgcn_mfma_f32_32x32x16_bf16(b1, qv, p1, 0, 0, 0); }
}
__device__ __forceinline__ int v_st(int k, int c) { const int kk = (k & ~0xC) | ((k & 4) << 1) | ((k & 8) >> 1); return ((kk >> 3) * 4 + (c >> 5)) * 512 + ((kk & 7) * 32 + (c & 31)) * 2; }
__device__ __forceinline__ int v_rd_base(int lane) { return ((lane & 3) << 3) | (((lane >> 2) & 3) << 6) | (((lane >> 4) & 1) << 5) | (((lane >> 5) & 1) << 8); }
constexpr int v_rd_off(int d0, int ks, int half) { return d0 * 512 + ks * 4096 + half * 2048; }
template <int OFF> __device__ __forceinline__ s16x4 tr_read(int vb) {
    s16x4 r; asm volatile("ds_read_b64_tr_b16 %0, %1 offset:%2" : "=&v"(r) : "v"(vb), "i"(OFF) : "memory"); return r;
}
template <int D0> __device__ __forceinline__ void pv_one(f32x16& od, int vb, bf16x8 pa0, bf16x8 pa1, bf16x8 pa2, bf16x8 pa3) {
    const s16x4 l0 = tr_read<v_rd_off(D0, 0, 0)>(vb), h0 = tr_read<v_rd_off(D0, 0, 1)>(vb), l1 = tr_read<v_rd_off(D0, 1, 0)>(vb), h1 = tr_read<v_rd_off(D0, 1, 1)>(vb);
    const s16x4 l2 = tr_read<v_rd_off(D0, 2, 0)>(vb), h2 = tr_read<v_rd_off(D0, 2, 1)>(vb), l3 = tr_read<v_rd_off(D0, 3, 0)>(vb), h3 = tr_read<v_rd_off(D0, 3, 1)>(vb);
    asm volatile("s_waitcnt lgkmcnt(0)" ::: "memory"); SBAR();
#define PK(L, H) (bf16x8){L[0], L[1], L[2], L[3], H[0], H[1], H[2], H[3]}
    od = __builtin_amdgcn_mfma_f32_32x32x16_bf16(pa0, PK(l0, h0), od, 0, 0, 0);
    od = __builtin_amdgcn_mfma_f32_32x32x16_bf16(pa1, PK(l1, h1), od, 0, 0, 0);
    od = __builtin_amdgcn_mfma_f32_32x32x16_bf16(pa2, PK(l2, h2), od, 0, 0, 0);
    od = __builtin_amdgcn_mfma_f32_32x32x16_bf16(pa3, PK(l3, h3), od, 0, 0, 0);
#undef PK
}
__device__ __forceinline__ void pv_d0(f32x16* o, int vb, bf16x8 pa0, bf16x8 pa1, bf16x8 pa2, bf16x8 pa3) {
    pv_one<0>(o[0], vb, pa0, pa1, pa2, pa3); pv_one<1>(o[1], vb, pa0, pa1, pa2, pa3); pv_one<2>(o[2], vb, pa0, pa1, pa2, pa3); pv_one<3>(o[3], vb, pa0, pa1, pa2, pa3);
}
__device__ __forceinline__ void attn_body(const bf16_t* __restrict__ Qb, const bf16_t* __restrict__ Kh, const bf16_t* __restrict__ Vh, bf16_t* __restrict__ Ob, int seq, char* lds, int wv) {
    const int lane = lane_id_v(), wid = wv, r32 = lane & 31, hi = lane >> 5;
    char* V_lds = lds; char* K_lds = lds + 2 * SHM_V;
    float* ws = (float*)(lds + 2 * SHM_V + 2 * SHM_K) + wid * 64; float* li_l = ws; float* al_l = ws + 32;
    float m_reg = -1e30f, l_reg = 0; f32x16 o[4] = {}; bf16x8 qr[NQR];
    const bf16_t* Qw = Qb + (long)(wid * QBLK + r32) * LDQ + hi * 8;
    char* qro = lds + 2 * SHM_V + 2 * SHM_K + 2048 + wid * ((12 - NQR) * 1024) + lane * 16;
#pragma unroll
    for (int d0 = 0; d0 < NQR; ++d0) qr[d0] = *reinterpret_cast<const bf16x8*>(Qw + d0 * 16);
#pragma unroll
    for (int d0 = NQR; d0 < 12; ++d0) *reinterpret_cast<bf16x8*>(qro + (d0 - NQR) * 1024) = *reinterpret_cast<const bf16x8*>(Qw + d0 * 16);
    const int wu = wv;
    unsigned ksrc[3], vsrc[2];
#pragma unroll
    for (int i = 0; i < 3; ++i) { const int pp = (i * 8 + wid) * 64 + lane, row = pp / 24, cpos = pp - row * 24, c = (cpos & ~7) | ((cpos ^ (row >> 1)) & 7); ksrc[i] = (unsigned)(row * 192 + c * 8) * 2u; }
#pragma unroll
    for (int i = 0; i < 2; ++i) { const int pp = (i * 8 + wid) * 64 + lane, kk = (pp >> 7) * 8 + ((pp & 31) >> 2), k = (kk & ~0xC) | ((kk & 4) << 1) | ((kk & 8) >> 1), c = ((pp >> 5) & 3) * 32 + (pp & 3) * 8;
        vsrc[i] = (unsigned)(k * 128 + c) * 2u; }
    LAS unsigned char* ldsl = (LAS unsigned char*)lds;
    const int vb0 = (int)(uintptr_t)V_lds + v_rd_base(lane);
#define DMA_K(k0, b) do { const char* kb_ = (const char*)Kh + (size_t)(k0) * 384; _Pragma("unroll") for (int i_ = 0; i_ < 3; ++i_) \
    __builtin_amdgcn_global_load_lds((const unsigned*)(kb_ + ksrc[i_]), (LAS unsigned*)(ldsl + 2 * SHM_V + (b) * SHM_K + (i_ * 8 + wu) * 1024), 16, 0, 0); } while (0)
#define DMA_V(k0, b) do { const char* vb_ = (const char*)Vh + (size_t)(k0) * 256; _Pragma("unroll") for (int i_ = 0; i_ < 2; ++i_) \
    __builtin_amdgcn_global_load_lds((const unsigned*)(vb_ + vsrc[i_]), (LAS unsigned*)(ldsl + (b) * SHM_V + (i_ * 8 + wu) * 1024), 16, 0, 0); } while (0)
#define ABAR1() do { asm volatile("s_waitcnt lgkmcnt(0)" ::: "memory"); __builtin_amdgcn_s_barrier(); asm volatile("" ::: "memory"); } while (0)
#define ABAR2(n) do { asm volatile("s_waitcnt vmcnt(" #n ") lgkmcnt(0)" ::: "memory"); __builtin_amdgcn_s_barrier(); asm volatile("" ::: "memory"); } while (0)
#define RESC(a) do { if (__any((a) < 1.f)) { if (hi == 0) al_l[r32] = (a); asm volatile("s_waitcnt lgkmcnt(0)" ::: "memory"); \
    _Pragma("unroll") for (int d = 0; d < 4; ++d) _Pragma("unroll") for (int r = 0; r < 16; ++r) o[d][r] *= al_l[crow(r, hi)]; } } while (0)
    f32x16 pA0, pA1, pB0, pB1; float mnA, mnB, alA, alB; bf16x8 pa0, pa1, pa2, pa3; const int NT = seq / KVBLK;
    DMA_K(0, 0); DMA_V(0, 0); ABAR2(0);
    DMA_K(KVBLK, 1);
    qkt(pA0, pA1, K_lds, qr, qro, r32, hi); partialSM(pA0, pA1, m_reg, mnA, alA);
    DMA_V(KVBLK, 1);
    ABAR2(2);
    for (int j = 1; j + 1 < NT; j += 2) {
        DMA_K((j + 1) * KVBLK, 0);
        SBAR(); qkt(pB0, pB1, K_lds + SHM_K, qr, qro, r32, hi);
        finishSM(pA0, pA1, alA, l_reg, pa0, pa1, pa2, pa3); SBAR();
        pv_d0(o, vb0, pa0, pa1, pa2, pa3); partialSM(pB0, pB1, m_reg, mnB, alB);
        ABAR1(); DMA_V((j + 1) * KVBLK, 0);
        RESC(alB); ABAR2(2);
        DMA_K((j + 2) * KVBLK, 1);
        SBAR(); qkt(pA0, pA1, K_lds, qr, qro, r32, hi);
        finishSM(pB0, pB1, alB, l_reg, pa0, pa1, pa2, pa3); SBAR();
        pv_d0(o, vb0 + SHM_V, pa0, pa1, pa2, pa3); partialSM(pA0, pA1, m_reg, mnA, alA);
        ABAR1(); DMA_V((j + 2) * KVBLK, 1);
        RESC(alA); ABAR2(2);
    }
    SBAR(); qkt(pB0, pB1, K_lds + SHM_K, qr, qro, r32, hi);
    finishSM(pA0, pA1, alA, l_reg, pa0, pa1, pa2, pa3); SBAR();
    pv_d0(o, vb0, pa0, pa1, pa2, pa3); partialSM(pB0, pB1, m_reg, mnB, alB);
    ABAR2(0); RESC(alB);
    finishSM(pB0, pB1, alB, l_reg, pa0, pa1, pa2, pa3); SBAR();
    pv_d0(o, vb0 + SHM_V, pa0, pa1, pa2, pa3);
    if (hi == 0) li_l[r32] = l_reg; asm volatile("s_waitcnt lgkmcnt(0)" ::: "memory");
    float rli[16];
#pragma unroll
    for (int r = 0; r < 16; ++r) rli[r] = __builtin_amdgcn_rcpf(li_l[crow(r, hi)]);
    bf16_t* Ow = Ob + (long)(wid * QBLK) * LDO;
#pragma unroll
    for (int r = 0; r < 16; ++r) { const int orow = crow(r, hi);
#pragma unroll
        for (int d0 = 0; d0 < 4; ++d0) Ow[(long)orow * LDO + d0 * 32 + r32] = f2bf(o[d0][r] * rli[r]); }
#undef DMA_K
#undef DMA_V
#undef ABAR1
#undef ABAR2
#undef RESC
}
}

__device__ __forceinline__ void convert_w(const float* __restrict__ src, bf16_t* __restrict__ dst, int K, int N, int mode, unsigned char* shm, int wv, int t0, int tstride, int ldk = 0) {
    if (ldk == 0) ldk = K;
    float* tile = (float*)shm;
    const int tid = TIDX(wv), nkg = K >> 8, nnt = N >> 6, total = nkg * nnt;
    f32x4 v[8];
#define CW_LOAD(T) do { const int kg_ = (T) % nkg, nt_ = (T) / nkg; _Pragma("unroll") for (int i = 0; i < 8; ++i) { const int r = (tid >> 4) + 32 * i, c4 = (tid & 15) * 4; \
        v[i] = __builtin_nontemporal_load((const f32x4*)(src + (size_t)(kg_ * 256 + r) * N + nt_ * 64 + c4)); } } while (0)
    if (t0 < total) CW_LOAD(t0);
    for (int t = t0; t < total; t += tstride) {
        const int kg = t % nkg, ntile = t / nkg;
#pragma unroll
        for (int i = 0; i < 8; ++i) {
            const int r = (tid >> 4) + 32 * i, c4 = (tid & 15) * 4;
            float* tp = tile + (r >> 6) * (64 * 65) + (r & 63) * 65 + c4;
            tp[0] = v[i][0]; tp[1] = v[i][1]; tp[2] = v[i][2]; tp[3] = v[i][3];
        }
        if (t + tstride < total) CW_LOAD(t + tstride);
        __syncthreads();
        const int n = tid >> 3, k8 = (tid & 7) * 8;
        const int ncol = ntile * 64 + n;
        int drow = ncol;
        if (mode == 1) { drow = (ncol < DFF) ? ((ncol >> 7) * 256 + (ncol & 127)) : (((ncol - DFF) >> 7) * 256 + 128 + ((ncol - DFF) & 127)); }
        if (mode == 2 && ncol < 1024) { const int d = ncol & 63, hf = d >> 5, rem = d & 31; drow = (ncol & ~63) + (rem >> 4) * 32 + ((rem & 15) >> 2) * 8 + hf * 4 + (rem & 3); }
#pragma unroll
        for (int q = 0; q < 4; ++q) {
            float f[8];
#pragma unroll
            for (int j = 0; j < 8; ++j) f[j] = tile[q * (64 * 65) + (k8 + j) * 65 + n];
            u32x4 w; w.x = cvt_pk_bf16(f[0], f[1]); w.y = cvt_pk_bf16(f[2], f[3]); w.z = cvt_pk_bf16(f[4], f[5]); w.w = cvt_pk_bf16(f[6], f[7]);
            *(u32x4*)(dst + (size_t)drow * ldk + kg * 256 + q * 64 + k8) = w;
        }
        __syncthreads();
    }
#undef CW_LOAD
}

__device__ __forceinline__ void phase_prep(const Params& p, unsigned char* shm, int wv) {
    const int lane = lane_id_v(), wid = wv, tid = wid * 64 + lane;
    unsigned char* ws = p.ws;
    float* sil = (float*)shm;
    float* red = sil + 6144;
    for (int i = tid; i < 6144; i += 512) { const float v = i < 4096 ? p.c[i] : p.c_ctx[i - 4096]; sil[i] = v / (1.0f + expf(-v)); }
    __syncthreads();
    float* mod = (float*)(ws + OFF_MOD);
    for (int unit = blockIdx.x; unit < 288; unit += gridDim.x) {
        const int col = unit * 64 + lane;
        const float* w = p.ada_w + (size_t)(wid * 256) * 18432 + col;
        float a0 = 0.f, a1 = 0.f, a2 = 0.f;
#pragma unroll 32
        for (int k = 0; k < 256; ++k) { const float wval = __builtin_nontemporal_load(w + (size_t)k * 18432); const int kk = wid * 256 + k; a0 += sil[kk] * wval; a1 += sil[2048 + kk] * wval; a2 += sil[4096 + kk] * wval; }
        red[(wid * 3 + 0) * 64 + lane] = a0; red[(wid * 3 + 1) * 64 + lane] = a1; red[(wid * 3 + 2) * 64 + lane] = a2;
        __syncthreads();
        if (tid < 192) { const int g = tid >> 6; float s = 0.f;
#pragma unroll
            for (int k = 0; k < 8; ++k) s += red[(k * 3 + g) * 64 + lane];
            mod[g * 18432 + col] = s + p.ada_b[col]; }
        __syncthreads();
    }
    const int gt = blockIdx.x * 512 + tid, gstride = gridDim.x * 512;
    float* rcos = (float*)(ws + OFF_RCOS); float* rsin = (float*)(ws + OFF_RSIN);
    for (int i = gt; i < 8192 * 32; i += gstride) { const int t = i >> 5, fi = i & 31; const float inv = exp2f(-(float)fi * (13.287712379549449f / 32.0f)); const float ang = (float)t * inv; rcos[i] = cosf(ang); rsin[i] = sinf(ang); }
    float* acos_ = (float*)(ws + OFF_ACOS); float* asin_ = (float*)(ws + OFF_ASIN);
    for (int i = gt; i < 128 * 16; i += gstride) { const int t = i >> 4, fi = i & 15; const float inv = exp2f(-(float)fi * (13.287712379549449f / 16.0f)); const float ang = (float)t * inv; acos_[i] = cosf(ang); asin_[i] = sinf(ang); }
    { u32x4* z = (u32x4*)(ws + OFF_WMIXIN + (size_t)PROJ_LD * LDH * 2); const u32x4 zero = {0u, 0u, 0u, 0u};
      for (int i = gt; i < (4096 - PROJ_LD) * LDH / 8; i += gstride) z[i] = zero; }
    convert_w(p.f1in, (bf16_t*)(ws + OFF_WF1IN), DM, 2 * DFF, 1, shm, wv, (int)blockIdx.x, (int)gridDim.x, LDH);
    convert_w(p.f1out, (bf16_t*)(ws + OFF_WF1OUT), DFF, DM, 0, shm, wv, (int)blockIdx.x, (int)gridDim.x);
    convert_w(p.mixin, (bf16_t*)(ws + OFF_WMIXIN), DM, PROJ_LD, 2, shm, wv, (int)blockIdx.x, (int)gridDim.x, LDH);
    convert_w(p.wuq, (bf16_t*)(ws + OFF_WUQ), 512, 1536, 0, shm, wv, (int)blockIdx.x, (int)gridDim.x);
    convert_w(p.wukv, (bf16_t*)(ws + OFF_WUKV), 256, 2048, 0, shm, wv, (int)blockIdx.x, (int)gridDim.x);
    convert_w(p.mixout, (bf16_t*)(ws + OFF_WMIXOUT), DM, DM, 0, shm, wv, (int)blockIdx.x, (int)gridDim.x, LDH);
}

__device__ __forceinline__ void phase_norm(const Params& p, int mode, const float* __restrict__ gvec, int midx, int nrows, int wv) {
    const int lane = lane_id_v(), wid = wv;
    const float* mod = (const float*)(p.ws + OFF_MOD);
    const float* xc = (const float*)(p.ws + OFF_XC);
    bf16_t* h = (bf16_t*)(p.ws + OFF_H);
    f32x4 A[8], Bv[8]; int curgrp = -1;
    for (int r = blockIdx.x * 8 + wid; r < nrows; r += gridDim.x * 8) {
        const int grp = r < NLAT ? (r >> 13) : 2;
        if (grp != curgrp) {
            curgrp = grp;
#pragma unroll
            for (int i = 0; i < 8; ++i) { const int c = i * 256 + lane * 4;
                const f32x4 g4 = *(const f32x4*)(gvec + c), sc4 = *(const f32x4*)(mod + (size_t)(grp * 9 + midx + 1) * DM + c), sh4 = *(const f32x4*)(mod + (size_t)(grp * 9 + midx) * DM + c);
                A[i] = g4 * (sc4 + 1.0f); Bv[i] = sh4; }
        }
        const float* src;
        if (r < NLAT) src = (mode == 0 ? p.x : p.out) + (size_t)r * DM; else src = (mode == 0 ? p.ctx : xc) + (size_t)(r - NLAT) * DM;
        f32x4 v[8]; float ss = 0.f;
#pragma unroll
        for (int i = 0; i < 8; ++i) { v[i] = *(const f32x4*)(src + i * 256 + lane * 4); ss += v[i][0] * v[i][0] + v[i][1] * v[i][1] + v[i][2] * v[i][2] + v[i][3] * v[i][3]; }
        ss = wave_sum(ss);
        const float rstd = rsqrtf(ss * (1.0f / DM) + 1e-6f);
#pragma unroll
        for (int i = 0; i < 8; ++i) { const f32x4 y = v[i] * rstd * A[i] + Bv[i]; u32x2 w; w.x = cvt_pk_bf16(y[0], y[1]); w.y = cvt_pk_bf16(y[2], y[3]);
            *(u32x2*)(h + (size_t)r * LDH + i * 256 + lane * 4) = w; }
    }
}
__device__ __forceinline__ void phase_norm_b(const Params& p, const float* __restrict__ gvec, int midx, int wv) {
    const int lane = lane_id_v(), wid = wv;
    const float* mod = (const float*)(p.ws + OFF_MOD);
    const bf16_t* xb = (const bf16_t*)(p.ws + OFF_XB);
    bf16_t* h = (bf16_t*)(p.ws + OFF_H);
    f32x4 A[8], Bv[8]; int curgrp = -1;
    for (int r = blockIdx.x * 8 + wid; r < NLAT; r += gridDim.x * 8) {
        const int grp = r >> 13;
        if (grp != curgrp) {
            curgrp = grp;
#pragma unroll
            for (int i = 0; i < 8; ++i) { const int c = (i >> 1) * 512 + lane * 8 + (i & 1) * 4;
                const f32x4 g4 = *(const f32x4*)(gvec + c), sc4 = *(const f32x4*)(mod + (size_t)(grp * 9 + midx + 1) * DM + c), sh4 = *(const f32x4*)(mod + (size_t)(grp * 9 + midx) * DM + c);
                A[i] = g4 * (sc4 + 1.0f); Bv[i] = sh4; }
        }
        f32x4 v[8]; float ss = 0.f;
#pragma unroll
        for (int i = 0; i < 4; ++i) { const u32x4 w = *(const u32x4*)(xb + (size_t)r * DM + i * 512 + lane * 8);
            v[2 * i] = (f32x4){bflo(w.x), bfhi(w.x), bflo(w.y), bfhi(w.y)}; v[2 * i + 1] = (f32x4){bflo(w.z), bfhi(w.z), bflo(w.w), bfhi(w.w)}; }
#pragma unroll
        for (int i = 0; i < 8; ++i) ss += v[i][0] * v[i][0] + v[i][1] * v[i][1] + v[i][2] * v[i][2] + v[i][3] * v[i][3];
        ss = wave_sum(ss);
        const float rstd = rsqrtf(ss * (1.0f / DM) + 1e-6f);
#pragma unroll
        for (int i = 0; i < 4; ++i) { const f32x4 y0 = v[2 * i] * rstd * A[2 * i] + Bv[2 * i], y1 = v[2 * i + 1] * rstd * A[2 * i + 1] + Bv[2 * i + 1];
            u32x4 w; w.x = cvt_pk_bf16(y0[0], y0[1]); w.y = cvt_pk_bf16(y0[2], y0[3]); w.z = cvt_pk_bf16(y1[0], y1[1]); w.w = cvt_pk_bf16(y1[2], y1[3]);
            *(u32x4*)(h + (size_t)r * LDH + i * 512 + lane * 8) = w; }
    }
}
__device__ __forceinline__ void phase_norm_ctx(const Params& p, int wv) {
    const int lane = lane_id_v(), wid = wv;
    const float* mod = (const float*)(p.ws + OFF_MOD);
    const float* part = (const float*)(p.ws + OFF_XC);
    bf16_t* h = (bf16_t*)(p.ws + OFF_H);
    for (int rr = blockIdx.x * 8 + wid; rr < 512; rr += gridDim.x * 8) {
        f32x4 v[8]; float ss = 0.f;
#pragma unroll
        for (int i = 0; i < 8; ++i) { const int c = i * 256 + lane * 4; const size_t o = (size_t)rr * DM + c;
            f32x4 s4 = *(const f32x4*)(part + o);
#pragma unroll
            for (int k = 1; k < 11; ++k) s4 += *(const f32x4*)(part + (size_t)k * 1048576 + o);
            v[i] = *(const f32x4*)(p.ctx + o) + *(const f32x4*)(mod + (size_t)(2 * 9 + 2) * DM + c) * 0.5f * s4;
            ss += v[i][0] * v[i][0] + v[i][1] * v[i][1] + v[i][2] * v[i][2] + v[i][3] * v[i][3]; }
        ss = wave_sum(ss);
        const float rstd = rsqrtf(ss * (1.0f / DM) + 1e-6f);
#pragma unroll
        for (int i = 0; i < 8; ++i) { const int c = i * 256 + lane * 4;
            const f32x4 g4 = *(const f32x4*)(p.n2g + c), sc4 = *(const f32x4*)(mod + (size_t)(2 * 9 + 4) * DM + c), sh4 = *(const f32x4*)(mod + (size_t)(2 * 9 + 3) * DM + c);
            const f32x4 y = v[i] * rstd * g4 * (sc4 + 1.0f) + sh4; u32x2 w; w.x = cvt_pk_bf16(y[0], y[1]); w.y = cvt_pk_bf16(y[2], y[3]);
            *(u32x2*)(h + (size_t)(NLAT + rr) * LDH + c) = w; }
    }
}
__device__ __forceinline__ void phase_final(const Params& p, int wv) {
    const int lane = lane_id_v(), wid = wv;
    f32x4 G[8];
#pragma unroll
    for (int i = 0; i < 8; ++i) G[i] = *(const f32x4*)(p.fng + i * 256 + lane * 4);
    for (int r = blockIdx.x * 8 + wid; r < NLAT; r += gridDim.x * 8) {
        float* row = p.out + (size_t)r * DM;
        f32x4 v[8]; float ss = 0.f;
#pragma unroll
        for (int i = 0; i < 8; ++i) { v[i] = *(const f32x4*)(row + i * 256 + lane * 4); ss += v[i][0] * v[i][0] + v[i][1] * v[i][1] + v[i][2] * v[i][2] + v[i][3] * v[i][3]; }
        ss = wave_sum(ss);
        const float rstd = rsqrtf(ss * (1.0f / DM) + 1e-6f);
#pragma unroll
        for (int i = 0; i < 8; ++i) __builtin_nontemporal_store(v[i] * rstd * G[i], (f32x4*)(row + i * 256 + lane * 4));
    }
}

struct TokIn { u32x4 cq; u32x2 ckv; float k0, k1, k2, k3; };
template <bool LAT> __device__ __forceinline__ void tok_load(TokIn& t, const bf16_t* __restrict__ proj, const float* __restrict__ krp, int r, int lane) {
    const bf16_t* row = proj + (size_t)r * PROJ_LD;
    if (LAT) t.cq = *(const u32x4*)(row + C_CQ + lane * 8);
    t.ckv = *(const u32x2*)(row + C_CKV + lane * 4);
    t.k0 = krp[(size_t)r * 64 + lane]; t.k1 = krp[((size_t)MALL + r) * 64 + lane]; t.k2 = krp[((size_t)2 * MALL + r) * 64 + lane]; t.k3 = krp[((size_t)3 * MALL + r) * 64 + lane];
}
template <bool LAT> __device__ __forceinline__ void tok_store(const TokIn& t, const Params& p, int r, int lane) {
    bf16_t* cqn = (bf16_t*)(p.ws + OFF_CQN); bf16_t* ckvn = (bf16_t*)(p.ws + OFF_CKVN); bf16_t* Kd = (bf16_t*)(p.ws + OFF_K);
    const float* axc = (const float*)(p.ws + OFF_ACOS); const float* axs = (const float*)(p.ws + OFF_ASIN);
    if (LAT) {
        const u32x4 w = t.cq;
        float f[8] = {bflo(w.x), bfhi(w.x), bflo(w.y), bfhi(w.y), bflo(w.z), bfhi(w.z), bflo(w.w), bfhi(w.w)};
        float ss = 0.f;
#pragma unroll
        for (int j = 0; j < 8; ++j) ss += f[j] * f[j];
        ss = wave_sum(ss);
        const float rstd = rsqrtf(ss * (1.0f / 512.0f) + 1e-6f);
        const f32x4 g0 = *(const f32x4*)(p.qng + lane * 8), g1 = *(const f32x4*)(p.qng + lane * 8 + 4);
        u32x4 o; o.x = cvt_pk_bf16(f[0] * rstd * g0[0], f[1] * rstd * g0[1]); o.y = cvt_pk_bf16(f[2] * rstd * g0[2], f[3] * rstd * g0[3]);
        o.z = cvt_pk_bf16(f[4] * rstd * g1[0], f[5] * rstd * g1[1]); o.w = cvt_pk_bf16(f[6] * rstd * g1[2], f[7] * rstd * g1[3]);
        *(u32x4*)(cqn + (size_t)r * 512 + lane * 8) = o;
    }
    {
        const u32x2 w = t.ckv;
        float f[4] = {bflo(w.x), bfhi(w.x), bflo(w.y), bfhi(w.y)};
        float ss = f[0] * f[0] + f[1] * f[1] + f[2] * f[2] + f[3] * f[3];
        ss = wave_sum(ss);
        const float rstd = rsqrtf(ss * (1.0f / 256.0f) + 1e-6f);
        const f32x4 g0 = *(const f32x4*)(p.kvng + lane * 4);
        u32x2 o; o.x = cvt_pk_bf16(f[0] * rstd * g0[0], f[1] * rstd * g0[1]); o.y = cvt_pk_bf16(f[2] * rstd * g0[2], f[3] * rstd * g0[3]);
        *(u32x2*)(ckvn + (size_t)r * 256 + lane * 4) = o;
    }
    {
        float me = (t.k0 + t.k1) + (t.k2 + t.k3);
        const float partner = __shfl_xor(me, 16);
        int b, key;
        if (LAT) {
            const int tt = r & 8191; b = r >> 13; key = tt;
            const int part = lane >> 5, i = lane & 15; const bool is2 = (lane & 16) != 0;
            const int pos = part == 0 ? (tt >> 6) : (tt & 63);
            const float cs = axc[pos * 16 + i], sn = axs[pos * 16 + i];
            me = is2 ? (me * cs + partner * sn) : (me * cs - partner * sn);
        } else { const int rr = r - NLAT; b = rr >> 8; key = 8192 + (rr & 255); }
        const bf16_t o = f2bf(me);
#pragma unroll
        for (int hh = 0; hh < 8; ++hh) Kd[((size_t)(b * 8 + hh) * SKV + key) * 192 + 128 + lane] = o;
    }
}
__device__ __forceinline__ void phase_tok(const Params& p, int wv) {
    const int lane = lane_id_v();
    const bf16_t* proj = (const bf16_t*)(p.ws + OFF_PROJ);
    const float* krp = (const float*)p.out + 16777216;
    const int stride = (int)gridDim.x * 8;
    for (int r = blockIdx.x * 8 + wv; r < NLAT; r += 2 * stride) {
        const int r2 = r + stride;
        TokIn a, b2;
        tok_load<true>(a, proj, krp, r, lane);
        if (r2 < NLAT) tok_load<true>(b2, proj, krp, r2, lane);
        tok_store<true>(a, p, r, lane);
        if (r2 < NLAT) tok_store<true>(b2, p, r2, lane);
    }
    for (int r = NLAT + blockIdx.x * 8 + wv; r < MALL; r += stride) { TokIn a; tok_load<false>(a, proj, krp, r, lane); tok_store<false>(a, p, r, lane); }
}

__device__ __forceinline__ float log_sigmoid_f(float x) { return -log1pf(expf(-x)); }
__device__ __forceinline__ void load_rot_pair(const bf16_t* __restrict__ rowp, bool rope, const float* __restrict__ rc, const float* __restrict__ rs, int q, float (&o1)[8], float (&o2)[8]) {
    const u32x4 a = *(const u32x4*)(rowp + 8 * q), b = *(const u32x4*)(rowp + 32 + 8 * q);
    const float x1[8] = {bflo(a.x), bfhi(a.x), bflo(a.y), bfhi(a.y), bflo(a.z), bfhi(a.z), bflo(a.w), bfhi(a.w)};
    const float x2[8] = {bflo(b.x), bfhi(b.x), bflo(b.y), bfhi(b.y), bflo(b.z), bfhi(b.z), bflo(b.w), bfhi(b.w)};
    if (rope) {
        const f32x4 c0 = *(const f32x4*)(rc + 8 * q), c1 = *(const f32x4*)(rc + 8 * q + 4), s0 = *(const f32x4*)(rs + 8 * q), s1 = *(const f32x4*)(rs + 8 * q + 4);
        const float cs[8] = {c0[0], c0[1], c0[2], c0[3], c1[0], c1[1], c1[2], c1[3]}, sn[8] = {s0[0], s0[1], s0[2], s0[3], s1[0], s1[1], s1[2], s1[3]};
#pragma unroll
        for (int i = 0; i < 8; ++i) { o1[i] = x1[i] * cs[i] - x2[i] * sn[i]; o2[i] = x2[i] * cs[i] + x1[i] * sn[i]; }
    } else {
#pragma unroll
        for (int i = 0; i < 8; ++i) { o1[i] = x1[i]; o2[i] = x2[i]; }
    }
}
__device__ __forceinline__ void stage_vT(const bf16_t* __restrict__ proj, int row0, int h, bf16_t* vT, int wv) {
    const int tid = TIDX(wv);
#pragma unroll
    for (int i = 0; i < 4; ++i) {
        const int id = tid + 512 * i, j = id & 127, ch = id >> 7;
        const u32x4 w = *(const u32x4*)(proj + (size_t)(row0 + j) * PROJ_LD + C_RV + h * 128 + ch * 8);
        bf16_t* d = vT + (ch * 8) * 136 + j;
        d[0 * 136] = (bf16_t)(w.x & 0xffff); d[1 * 136] = (bf16_t)(w.x >> 16); d[2 * 136] = (bf16_t)(w.y & 0xffff); d[3 * 136] = (bf16_t)(w.y >> 16);
        d[4 * 136] = (bf16_t)(w.z & 0xffff); d[5 * 136] = (bf16_t)(w.z >> 16); d[6 * 136] = (bf16_t)(w.w & 0xffff); d[7 * 136] = (bf16_t)(w.w >> 16);
    }
}
__device__ __forceinline__ void phase_ret_kv(const Params& p, unsigned char* shm, int wv) {
    const int lane = lane_id_v(), wid = wv, tid = wid * 64 + lane, r32 = lane & 31, hi = lane >> 5;
    const bf16_t* proj = (const bf16_t*)(p.ws + OFF_PROJ);
    float* states = (float*)(p.ws + OFF_STATES);
    const float* rcos = (const float*)(p.ws + OFF_RCOS); const float* rsin = (const float*)(p.ws + OFF_RSIN);
    bf16_t* kTf = (bf16_t*)shm; bf16_t* kTb = kTf + 64 * 136; bf16_t* vT = kTb + 64 * 136;
    for (int u = blockIdx.x; u < 16 * 66; u += gridDim.x) {
        const int bh = u / 66, cidx = u % 66, b = bh >> 3, h = bh & 7;
        int row0, slot_f, slot_b, t0; bool rope;
        if (cidx < 2) { row0 = NLAT + b * 256 + cidx * 128; rope = false; t0 = 0; slot_f = cidx; slot_b = 1 - cidx; }
        else { const int c = cidx - 2; row0 = b * 8192 + c * 128; rope = true; t0 = c * 128; slot_f = 2 + c; slot_b = 2 + 63 - c; }
        const float lf2 = log_sigmoid_f(p.rdf[h]) * LOG2E, lb2 = log_sigmoid_f(p.rdb[h]) * LOG2E;
        __syncthreads();
        {
            const int j = tid >> 2, q = tid & 3;
            float o1[8], o2[8];
            load_rot_pair(proj + (size_t)(row0 + j) * PROJ_LD + C_RK + h * 64, false, rcos, rsin, q, o1, o2);
            const float zf = exp2f(lf2 * (float)(127 - j)), zb = exp2f(lb2 * (float)j);
#pragma unroll
            for (int i = 0; i < 8; ++i) {
                kTf[(8 * q + i) * 136 + j] = f2bf(o1[i] * zf); kTf[(32 + 8 * q + i) * 136 + j] = f2bf(o2[i] * zf);
                kTb[(8 * q + i) * 136 + j] = f2bf(o1[i] * zb); kTb[(32 + 8 * q + i) * 136 + j] = f2bf(o2[i] * zb);
            }
        }
        stage_vT(proj, row0, h, vT, wv);
        __syncthreads();
        const int me = wid & 3, dir = wid >> 2;
        const bf16_t* kT = dir ? kTb : kTf;
        f32x16 acc0 = {}, acc1 = {};
#pragma unroll
        for (int ks = 0; ks < 8; ++ks) {
            const int tok = 16 * ks + 8 * hi;
            const bf16x8 a = *(const bf16x8*)(vT + (32 * me + r32) * 136 + tok);
            const bf16x8 b0 = *(const bf16x8*)(kT + r32 * 136 + tok), b1 = *(const bf16x8*)(kT + (32 + r32) * 136 + tok);
            acc0 = __builtin_amdgcn_mfma_f32_32x32x16_bf16(a, b0, acc0, 0, 0, 0);
            acc1 = __builtin_amdgcn_mfma_f32_32x32x16_bf16(a, b1, acc1, 0, 0, 0);
        }
        float* dst = states + ((size_t)((bh * 2 + dir) * 66 + (dir ? slot_b : slot_f))) * 8192;
#pragma unroll
        for (int r = 0; r < 16; ++r) { const int e = 32 * me + att::crow(r, hi); dst[e * 64 + r32] = acc0[r]; dst[e * 64 + 32 + r32] = acc1[r]; }
    }
}
__device__ __forceinline__ void phase_scan(const Params& p, int wv) {
    const float* states = (const float*)(p.ws + OFF_STATES);
    unsigned* sb = (unsigned*)p.out;
    for (int idx = blockIdx.x * 512 + TIDX(wv); idx < 32 * 4096; idx += gridDim.x * 512) {
        const int bhd = idx >> 12, e2 = (idx & 4095) * 2, h = (bhd >> 1) & 7, dir = bhd & 1;
        const float lg = log_sigmoid_f(dir ? p.rdb[h] : p.rdf[h]); const float decay = expf(lg * 128.0f);
        const f32x2* base = (const f32x2*)(states + (size_t)bhd * 66 * 8192 + e2);
        unsigned* ob = sb + ((size_t)bhd * 66 * 8192 + e2) / 2;
        f32x2 S = {0.f, 0.f};
        for (int s0 = 0; s0 < 66; s0 += 22) {
            f32x2 v[22];
#pragma unroll
            for (int k = 0; k < 22; ++k) v[k] = base[(size_t)(s0 + k) * 4096];
#pragma unroll
            for (int k = 0; k < 22; ++k) { ob[(size_t)(s0 + k) * 4096] = cvt_pk_bf16(S[0], S[1]); S = S * decay + v[k]; }
        }
    }
}
__device__ __forceinline__ void ret_out_unit(const Params& p, unsigned char* shm, int u, int wv) {
    const int lane = lane_id_v(), w = wv, tid = w * 64 + lane, l15 = lane & 15, g = lane >> 4;
    const bf16_t* proj = (const bf16_t*)(p.ws + OFF_PROJ);
    const float* states = (const float*)(p.ws + OFF_STATES);
    const float* rcos = (const float*)(p.ws + OFF_RCOS); const float* rsin = (const float*)(p.ws + OFF_RSIN);
    bf16_t* mixcat = (bf16_t*)(p.ws + OFF_H);
    bf16_t* qs = (bf16_t*)shm; bf16_t* ksm = qs + 128 * 72; bf16_t* vT = ksm + 128 * 72; bf16_t* SfT = vT + 128 * 136; bf16_t* SbT = SfT + 128 * 72;
    const int bh = u >> 6, c = u & 63, b = bh >> 3, h = bh & 7;
    const int row0 = b * 8192 + c * 128, t0 = c * 128;
    const float lf2 = log_sigmoid_f(p.rdf[h]) * LOG2E, lb2 = log_sigmoid_f(p.rdb[h]) * LOG2E;
    {
        const int j = tid >> 2, q = tid & 3;
        const bf16_t* qp = proj + (size_t)(row0 + j) * PROJ_LD + C_RQ + h * 64;
        const bf16_t* kp = proj + (size_t)(row0 + j) * PROJ_LD + C_RK + h * 64;
        const u32x4 q1 = *(const u32x4*)(qp + 8 * q), q2 = *(const u32x4*)(qp + 32 + 8 * q), k1 = *(const u32x4*)(kp + 8 * q), k2 = *(const u32x4*)(kp + 32 + 8 * q);
        *(u32x4*)(qs + j * 72 + 8 * q) = q1; *(u32x4*)(qs + j * 72 + 32 + 8 * q) = q2;
        *(u32x4*)(ksm + j * 72 + 8 * q) = k1; *(u32x4*)(ksm + j * 72 + 32 + 8 * q) = k2;
    }
    stage_vT(proj, row0, h, vT, wv);
    {
        const bf16_t* sbf = (const bf16_t*)p.out;
        const bf16_t* Sf = sbf + ((size_t)((bh * 2 + 0) * 66 + 2 + c)) * 8192;
        const bf16_t* Sb = sbf + ((size_t)((bh * 2 + 1) * 66 + 2 + 63 - c)) * 8192;
#pragma unroll
        for (int i = 0; i < 2; ++i) {
            const int id = tid + 512 * i, e = id >> 3, d8 = (id & 7) * 8;
            *(u32x4*)(SfT + e * 72 + d8) = *(const u32x4*)(Sf + e * 64 + d8);
            *(u32x4*)(SbT + e * 72 + d8) = *(const u32x4*)(Sb + e * 64 + d8);
        }
    }
    __syncthreads();
    bf16x8 qf[2];
#pragma unroll
    for (int ks = 0; ks < 2; ++ks) qf[ks] = *(const bf16x8*)(qs + (16 * w + l15) * 72 + 32 * ks + 8 * g);
    f32x4 st[8];
    const int qi = 16 * w + l15;
#pragma unroll
    for (int t = 0; t < 8; ++t) {
        f32x4 a = {0.f, 0.f, 0.f, 0.f};
#pragma unroll
        for (int ks = 0; ks < 2; ++ks) { const bf16x8 kf = *(const bf16x8*)(ksm + (16 * t + l15) * 72 + 32 * ks + 8 * g); a = __builtin_amdgcn_mfma_f32_16x16x32_bf16(kf, qf[ks], a, 0, 0, 0); }
#pragma unroll
        for (int r = 0; r < 4; ++r) { const int kj = 16 * t + 4 * g + r; const int dl = qi - kj; const float f = dl >= 0 ? exp2f(lf2 * (float)dl) : exp2f(-lb2 * (float)dl); a[r] *= f; }
        st[t] = a;
    }
    f32x4 y[8];
#pragma unroll
    for (int nt = 0; nt < 8; ++nt) y[nt] = (f32x4){0.f, 0.f, 0.f, 0.f};
#pragma unroll
    for (int T = 0; T < 4; ++T) {
        u32x4 pw; pw.x = cvt_pk_bf16(st[2 * T][0], st[2 * T][1]); pw.y = cvt_pk_bf16(st[2 * T][2], st[2 * T][3]); pw.z = cvt_pk_bf16(st[2 * T + 1][0], st[2 * T + 1][1]); pw.w = cvt_pk_bf16(st[2 * T + 1][2], st[2 * T + 1][3]);
        const bf16x8 pa = *reinterpret_cast<const bf16x8*>(&pw);
#pragma unroll
        for (int nt = 0; nt < 8; ++nt) {
            const bf16_t* vp = vT + (16 * nt + l15) * 136 + 32 * T + 4 * g;
            const u32x2 lo = *(const u32x2*)vp, hi2 = *(const u32x2*)(vp + 16);
            u32x4 bw; bw.x = lo.x; bw.y = lo.y; bw.z = hi2.x; bw.w = hi2.y;
            y[nt] = __builtin_amdgcn_mfma_f32_16x16x32_bf16(pa, *reinterpret_cast<const bf16x8*>(&bw), y[nt], 0, 0, 0);
        }
    }
    float xif[4], xib[4];
#pragma unroll
    for (int r = 0; r < 4; ++r) { const int il = 16 * w + 4 * g + r; xif[r] = exp2f(lf2 * (float)(il + 1)); xib[r] = exp2f(lb2 * (float)(128 - il)); }
#pragma unroll
    for (int nt = 0; nt < 8; ++nt) {
        f32x4 tf = {0.f, 0.f, 0.f, 0.f}, tb = {0.f, 0.f, 0.f, 0.f};
#pragma unroll
        for (int ks = 0; ks < 2; ++ks) {
            const bf16x8 sf = *(const bf16x8*)(SfT + (16 * nt + l15) * 72 + 32 * ks + 8 * g), sb = *(const bf16x8*)(SbT + (16 * nt + l15) * 72 + 32 * ks + 8 * g);
            tf = __builtin_amdgcn_mfma_f32_16x16x32_bf16(qf[ks], sf, tf, 0, 0, 0);
            tb = __builtin_amdgcn_mfma_f32_16x16x32_bf16(qf[ks], sb, tb, 0, 0, 0);
        }
#pragma unroll
        for (int r = 0; r < 4; ++r) y[nt][r] += xif[r] * tf[r] + xib[r] * tb[r];
    }
    f32x4 yn[8];
#pragma unroll
    for (int r = 0; r < 4; ++r) {
        float s = 0.f;
#pragma unroll
        for (int nt = 0; nt < 8; ++nt) s += y[nt][r];
        s += __shfl_xor(s, 1); s += __shfl_xor(s, 2); s += __shfl_xor(s, 4); s += __shfl_xor(s, 8);
        const float mu = s * (1.0f / 128.0f);
        float q2 = 0.f;
#pragma unroll
        for (int nt = 0; nt < 8; ++nt) { const float d = y[nt][r] - mu; q2 += d * d; }
        q2 += __shfl_xor(q2, 1); q2 += __shfl_xor(q2, 2); q2 += __shfl_xor(q2, 4); q2 += __shfl_xor(q2, 8);
        const float rstd = rsqrtf(q2 * (1.0f / 128.0f) + 1e-5f);
#pragma unroll
        for (int nt = 0; nt < 8; ++nt) yn[nt][r] = (y[nt][r] - mu) * rstd;
    }
    __syncthreads();
    float* yt = (float*)shm;
#pragma unroll
    for (int r = 0; r < 4; ++r)
#pragma unroll
        for (int nt = 0; nt < 8; ++nt) yt[(16 * w + 4 * g + r) * 132 + 16 * nt + l15] = yn[nt][r];
    __syncthreads();
#pragma unroll
    for (int i = 0; i < 4; ++i) {
        const int id = tid + 512 * i, tok = id >> 4, c8 = (id & 15) * 8;
        const size_t row = (size_t)(row0 + tok);
        const u32x4 gw = *(const u32x4*)(proj + row * PROJ_LD + C_RG + h * 128 + c8);
        const f32x4 a = *(const f32x4*)(yt + tok * 132 + c8), b = *(const f32x4*)(yt + tok * 132 + c8 + 4);
        u32x4 o;
        o.x = cvt_pk_bf16(a[0] * silu_f(bflo(gw.x)), a[1] * silu_f(bfhi(gw.x))); o.y = cvt_pk_bf16(a[2] * silu_f(bflo(gw.y)), a[3] * silu_f(bfhi(gw.y)));
        o.z = cvt_pk_bf16(b[0] * silu_f(bflo(gw.z)), b[1] * silu_f(bfhi(gw.z))); o.w = cvt_pk_bf16(b[2] * silu_f(bflo(gw.w)), b[3] * silu_f(bfhi(gw.w)));
        *(u32x4*)(mixcat + row * LDH + h * 128 + c8) = o;
    }
}

#define XB_TMO      128
#define XB_XCNT(j)  (256  + 64 * (j))
#define XB_XSUB(j)  (1280 + 64 * (j))
#define XB_XGEN(j)  (2304 + 64 * (j))
#define XB_TOP      3328
#define XB_TOPGEN   3392
#define XCD_BAR_WORDS 3456
#define XB_SPIN_CAP (1u << 22)
__device__ __forceinline__ unsigned xb_ld(unsigned* p)              { return __hip_atomic_load(p, __ATOMIC_RELAXED, __HIP_MEMORY_SCOPE_AGENT); }
__device__ __forceinline__ unsigned xb_add(unsigned* p, unsigned v) { return __hip_atomic_fetch_add(p, v, __ATOMIC_RELAXED, __HIP_MEMORY_SCOPE_AGENT); }
__device__ __forceinline__ unsigned xb_xcc_id() { return (unsigned)__builtin_amdgcn_s_getreg((3 << 11) | 20) & 0xFu; }
#define XB_SPIN(cond, bar) do { unsigned _sp = 0; while (cond) { __builtin_amdgcn_s_sleep(1); \
    if ((++_sp & 255u) == 0u) { if (xb_ld(&(bar)[XB_TMO])) break; if (_sp > XB_SPIN_CAP) { atomicAdd(&(bar)[XB_TMO], 1u); break; } } } } while (0)
struct XcdBarrier { unsigned* bar; unsigned x; volatile LAS unsigned* st; };
__device__ __forceinline__ XcdBarrier xcd_barrier_post(unsigned* bar, volatile LAS unsigned* st, int wv) {
    XcdBarrier b; b.bar = bar; b.x = xb_xcc_id(); b.st = st;
    if (wv == 0 && lane_id_v() == 0) (void)xb_add(&bar[XB_XCNT(b.x)], 1u);
    return b;
}
__device__ __forceinline__ void xcd_barrier_complete(unsigned* bar, unsigned x, unsigned& nloc, unsigned& nx) {
    const unsigned G = gridDim.x * gridDim.y * gridDim.z;
    unsigned sum, cnt, mine, sp = 0u;
    for (;;) {
        sum = 0u; cnt = 0u; mine = 0u;
#pragma unroll
        for (unsigned j = 0; j < 16; ++j) { const unsigned c = xb_ld(&bar[XB_XCNT(j)]); sum += c; cnt += (c > 0u) ? 1u : 0u; mine = (j == x) ? c : mine; }
        if (sum == G) break;
        __builtin_amdgcn_s_sleep(1);
        if ((++sp & 255u) == 0u) { if (xb_ld(&bar[XB_TMO])) break; if (sp > XB_SPIN_CAP) { atomicAdd(&bar[XB_TMO], 1u); break; } }
    }
    nloc = mine > 0u ? mine : 1u; nx = cnt > 0u ? cnt : 1u;
}
__device__ __forceinline__ void xcd_barrier(const XcdBarrier& b, int wv) {
    asm volatile("s_waitcnt vmcnt(0)" ::: "memory");
    __syncthreads();
    if (wv == 0 && lane_id_v() == 0) {
        unsigned* bar = b.bar;
        __builtin_amdgcn_s_waitcnt(0);
        unsigned nloc = b.st[0], nx = b.st[1];
        if (nloc == 0u) { xcd_barrier_complete(bar, b.x, nloc, nx); b.st[0] = nloc; b.st[1] = nx; }
        const unsigned old = xb_add(&bar[XB_XSUB(b.x)], 1u);
        const unsigned gen = old / nloc;
        if (old + 1u == (gen + 1u) * nloc) {
            __builtin_amdgcn_fence(__ATOMIC_RELEASE, "agent");
            asm volatile("s_waitcnt vmcnt(0)" ::: "memory");
            const unsigned og = xb_add(&bar[XB_TOP], 1u);
            const unsigned tg = og / nx;
            if (og + 1u == (tg + 1u) * nx) xb_add(&bar[XB_TOPGEN], 1u);
            else XB_SPIN(xb_ld(&bar[XB_TOPGEN]) == tg, bar);
            __builtin_amdgcn_fence(__ATOMIC_ACQUIRE, "agent");
            xb_add(&bar[XB_XGEN(b.x)], 1u);
            asm volatile("s_waitcnt vmcnt(0)" ::: "memory");
        } else {
            XB_SPIN(xb_ld(&bar[XB_XGEN(b.x)]) == gen, bar);
            __builtin_amdgcn_fence(__ATOMIC_ACQUIRE, "agent");
            asm volatile("s_waitcnt vmcnt(0)" ::: "memory");
        }
    }
    __syncthreads();
}

__global__ void __launch_bounds__(512, 2) mega(Params p) {
    extern __shared__ __attribute__((aligned(16))) unsigned char shm[];
    cg::grid_group grid = cg::this_grid();
    volatile LAS unsigned* xst = (volatile LAS unsigned*)(LAS unsigned char*)(shm + 131072);
    unsigned* bar = (unsigned*)(p.ws + OFF_BAR);
    const int wv = __builtin_amdgcn_readfirstlane((int)(threadIdx.x >> 6));
    if (wv == 0 && lane_id_v() == 0) { xst[0] = 0u; xst[1] = 0u; }
    if (blockIdx.x == 0) { for (int i = TIDX(wv); i < XCD_BAR_WORDS; i += 512) bar[i] = 0u; }
    __syncthreads();
    unsigned char* ws = p.ws;
    float* mod = (float*)(ws + OFF_MOD);
    float* xc = (float*)(ws + OFF_XC);
    bf16_t* hbuf = (bf16_t*)(ws + OFF_H);
    bf16_t* act = (bf16_t*)(ws + OFF_ACT);
#ifndef PH_MASK
#define PH_MASK 0x3fff
#endif
#define PHASE(k) if ((PH_MASK >> (k)) & 1)
#define SYNC(k) xcd_barrier(xb, wv)
    PHASE(0) { phase_prep(p, shm, wv); }
    grid.sync();
    const XcdBarrier xb = xcd_barrier_post(bar, xst, wv);
    PHASE(1) { phase_norm(p, 0, p.n1g, 0, MALL, wv); } SYNC(1);
    PHASE(2) { { EpiSwiglu E; E.O = act; run_gemm(shm, hbuf, (const bf16_t*)(ws + OFF_WF1IN), MALL, 2 * DFF, DM, E, wv, -1, LDH, LDH); }
               const int extra = (MALL / 256) * (2 * DFF / 256) - 11 * (int)gridDim.x;
               if (gridDim.x == 256 && (int)blockIdx.x >= extra) { const int t0 = (int)blockIdx.x - extra, ts = (int)gridDim.x - extra;
                   convert_w(p.f2in, (bf16_t*)(ws + OFF_WF2IN), DM, 2 * DFF, 1, shm, wv, t0, ts, LDH); convert_w(p.f2out, (bf16_t*)(ws + OFF_WF2OUT), DFF, DM, 0, shm, wv, t0, ts); }
               else if (gridDim.x != 256) { convert_w(p.f2in, (bf16_t*)(ws + OFF_WF2IN), DM, 2 * DFF, 1, shm, wv, (int)blockIdx.x, (int)gridDim.x, LDH); convert_w(p.f2out, (bf16_t*)(ws + OFF_WF2OUT), DFF, DM, 0, shm, wv, (int)blockIdx.x, (int)gridDim.x); } } SYNC(2);
    PHASE(3) { { EpiResidB<true, false> E; E.basef = p.x; E.baseb = nullptr; E.outf = nullptr; E.outb = (bf16_t*)(ws + OFF_XB); E.mod = mod; E.gidx = 2; E.coef = 0.5f;
                 run_gemm(shm, act, (const bf16_t*)(ws + OFF_WF1OUT), NLAT, DM, DFF, E, wv); }
               { EpiPartial E; E.part = xc;
                 run_gemm_splitk<EpiPartial, 2>(shm, act + (size_t)NLAT * DFF, (const bf16_t*)(ws + OFF_WF1OUT), DM, DFF, 11, E, wv); } } SYNC(3);
    PHASE(4) { phase_norm_b(p, p.n2g, 3, wv); phase_norm_ctx(p, wv); } SYNC(4);
    PHASE(5) { { EpiProj E; E.O = (bf16_t*)(ws + OFF_PROJ); E.rcos = (const float*)(ws + OFF_RCOS); E.rsin = (const float*)(ws + OFF_RSIN);
                 run_gemm(shm, hbuf, (const bf16_t*)(ws + OFF_WMIXIN), MALL, 3840, DM, E, wv, -1, LDH, LDH); }
               { EpiKrPart E; E.part = p.out + 16777216;
                 run_gemm_splitk<EpiKrPart, 66>(shm, hbuf, (const bf16_t*)(ws + OFF_WMIXIN) + (size_t)3840 * LDH, 256, DM, 4, E, wv, LDH, (int)((blockIdx.x + 34) % gridDim.x)); } } SYNC(5);
    PHASE(6) { phase_tok(p, wv); phase_ret_kv(p, shm, wv); } SYNC(6);
    PHASE(7) { phase_scan(p, wv);
               { EpiQ E; E.Q = (bf16_t*)(ws + OFF_Q); E.axc = (const float*)(ws + OFF_ACOS); E.axs = (const float*)(ws + OFF_ASIN);
                 run_gemm(shm, (const bf16_t*)(ws + OFF_CQN), (const bf16_t*)(ws + OFF_WUQ), NLAT, 1536, 512, E, wv); }
               { EpiKV E; E.Kd = (bf16_t*)(ws + OFF_K); E.Vd = (bf16_t*)(ws + OFF_V); E.pm0 = 0;
                 run_gemm(shm, (const bf16_t*)(ws + OFF_CKVN), (const bf16_t*)(ws + OFF_WUKV), NLAT, 2048, 256, E, wv);
                 E.pm0 = 64;
                 run_gemm(shm, (const bf16_t*)(ws + OFF_CKVN) + (size_t)NLAT * 256, (const bf16_t*)(ws + OFF_WUKV), 512, 2048, 256, E, wv, (int)((blockIdx.x + gridDim.x / 2) % gridDim.x)); } } SYNC(7);
    PHASE(8) {
#ifndef NO_ATT
        for (int u = blockIdx.x; u < 512; u += gridDim.x) {
            const int b = u >> 8, rem = u & 255, h = rem & 7, qb = rem >> 3;
            const bf16_t* Qb = (const bf16_t*)(ws + OFF_Q) + (size_t)(b * 8192 + qb * 256) * 1536 + h * 192;
            const bf16_t* Kh = (const bf16_t*)(ws + OFF_K) + (size_t)(b * 8 + h) * SKV * 192;
            const bf16_t* Vh = (const bf16_t*)(ws + OFF_V) + (size_t)(b * 8 + h) * SKV * 128;
            bf16_t* Ob = hbuf + (size_t)(b * 8192 + qb * 256) * LDH + 1024 + h * 128;
            __syncthreads();
            att::attn_body(Qb, Kh, Vh, Ob, SKV, (char*)shm, wv);
        }
#endif
#ifndef NO_RET3
        for (int u = blockIdx.x; u < 1024; u += gridDim.x) { __syncthreads(); ret_out_unit(p, shm, u, wv); }
#endif
    } SYNC(8);
    PHASE(9) { EpiResidB<false, false> E; E.basef = nullptr; E.baseb = (const bf16_t*)(ws + OFF_XB); E.outf = nullptr; E.outb = (bf16_t*)(ws + OFF_XB); E.mod = mod; E.gidx = 5; E.coef = 1.0f;
               run_gemm(shm, hbuf, (const bf16_t*)(ws + OFF_WMIXOUT), NLAT, DM, DM, E, wv, -1, LDH, LDH); } SYNC(9);
    PHASE(10) { phase_norm_b(p, p.n3g, 6, wv); } SYNC(10);
    PHASE(11) { EpiSwiglu E; E.O = act; run_gemm(shm, hbuf, (const bf16_t*)(ws + OFF_WF2IN), NLAT, 2 * DFF, DM, E, wv, -1, LDH, LDH); } SYNC(11);
    PHASE(12) { EpiResidB<false, true> E; E.basef = nullptr; E.baseb = (const bf16_t*)(ws + OFF_XB); E.outf = p.out; E.outb = nullptr; E.mod = mod; E.gidx = 8; E.coef = 0.5f;
                run_gemm(shm, act, (const bf16_t*)(ws + OFF_WF2OUT), NLAT, DM, DFF, E, wv); } SYNC(12);
    PHASE(13) { phase_final(p, wv); }
#undef PHASE
#undef SYNC
}

extern "C" void kernel_launch(void* const* d_in, const int* in_sizes, int n_in, void* d_out, int out_size, void* d_ws, size_t ws_size, hipStream_t stream) {
    static int grid_blocks = 0;
    if (!grid_blocks) {
        if (n_in != 22 || ws_size < WS_END || out_size != NLAT * DM) { fprintf(stderr, "kernel_launch: unexpected shapes n_in %d ws %zu (need %zu) out %d\n", n_in, ws_size, (size_t)WS_END, out_size); return; }
        if (hipFuncSetAttribute((const void*)mega, hipFuncAttributeMaxDynamicSharedMemorySize, LDS_BYTES) != hipSuccess) { fprintf(stderr, "kernel_launch: hipFuncSetAttribute failed\n"); return; }
        int dev = 0, cus = 0, per_cu = 0;
        hipGetDevice(&dev);
        hipDeviceGetAttribute(&cus, hipDeviceAttributeMultiprocessorCount, dev);
        hipOccupancyMaxActiveBlocksPerMultiprocessor(&per_cu, mega, 512, LDS_BYTES);
        if (per_cu < 1) { fprintf(stderr, "kernel_launch: occupancy 0\n"); return; }
        grid_blocks = cus;
    }
    Params p{};
    p.x = (const float*)d_in[0]; p.c = (const float*)d_in[1]; p.ctx = (const float*)d_in[2]; p.c_ctx = (const float*)d_in[3]; p.ada_w = (const float*)d_in[4]; p.ada_b = (const float*)d_in[5];
    p.n1g = (const float*)d_in[6]; p.f1in = (const float*)d_in[7]; p.f1out = (const float*)d_in[8]; p.n2g = (const float*)d_in[9]; p.mixin = (const float*)d_in[10];
    p.rdf = (const float*)d_in[11]; p.rdb = (const float*)d_in[12]; p.qng = (const float*)d_in[13]; p.wuq = (const float*)d_in[14]; p.kvng = (const float*)d_in[15]; p.wukv = (const float*)d_in[16];
    p.mixout = (const float*)d_in[17]; p.n3g = (const float*)d_in[18]; p.f2in = (const float*)d_in[19]; p.f2out = (const float*)d_in[20]; p.fng = (const float*)d_in[21];
    p.out = (float*)d_out; p.ws = (unsigned char*)d_ws;
    void* args[] = {&p};
    hipError_t e = hipLaunchCooperativeKernel((void*)mega, dim3(grid_blocks), dim3(512), args, LDS_BYTES, stream);
    if (e != hipSuccess) fprintf(stderr, "cooperative launch failed: %s (grid %d)\n", hipGetErrorString(e), grid_blocks);
}
```

```cpp
#include <hip/hip_runtime.h>
#include <hip/hip_cooperative_groups.h>
#include <cstdio>
#include <cstdint>
namespace cg = cooperative_groups;

typedef unsigned short bf16_t;
typedef short bf16x8 __attribute__((ext_vector_type(8)));
typedef short s16x4 __attribute__((ext_vector_type(4)));
typedef float f32x4 __attribute__((ext_vector_type(4)));
typedef float f32x2 __attribute__((ext_vector_type(2)));
typedef float f32x16 __attribute__((ext_vector_type(16)));
typedef unsigned u32x4 __attribute__((ext_vector_type(4)));
typedef unsigned u32x2 __attribute__((ext_vector_type(2)));
#define LAS __attribute__((address_space(3)))

constexpr int NLAT = 16384, MALL = 16896, DM = 2048, DFF = 5632, PROJ_LD = 3904, SKV = 8448;
constexpr int C_RQ = 0, C_RK = 512, C_RV = 1024, C_RG = 2048, C_CQ = 3072, C_CKV = 3584, C_KR = 3840;
constexpr int LDH = 2112;
constexpr int LDS_BYTES = 131072 + 16;
constexpr float LOG2E = 1.4426950408889634f;

constexpr size_t OFF_MOD = 0;
constexpr size_t OFF_RCOS = OFF_MOD + 221184;
constexpr size_t OFF_RSIN = OFF_RCOS + 1048576;
constexpr size_t OFF_ACOS = OFF_RSIN + 1048576;
constexpr size_t OFF_ASIN = OFF_ACOS + 8192;
constexpr size_t OFF_WF1IN = OFF_ASIN + 8192;
constexpr size_t OFF_WF1OUT = OFF_WF1IN + (size_t)11264 * LDH * 2;
constexpr size_t OFF_STATES = OFF_WF1IN;
constexpr size_t OFF_WF2IN = OFF_WF1OUT + 23068672;
constexpr size_t OFF_WF2OUT = OFF_WF2IN + (size_t)11264 * LDH * 2;
constexpr size_t OFF_WMIXIN = OFF_WF2OUT + 23068672;
constexpr size_t OFF_WUQ = OFF_WMIXIN + (size_t)4096 * LDH * 2;
constexpr size_t OFF_WUKV = OFF_WUQ + 1572864;
constexpr size_t OFF_WMIXOUT = OFF_WUKV + 1048576;
constexpr size_t OFF_H = OFF_WMIXOUT + (size_t)2048 * LDH * 2;
constexpr size_t OFF_BIG = OFF_H + (size_t)16896 * LDH * 2;
constexpr size_t OFF_XC = OFF_BIG + 209715200;
constexpr size_t OFF_ACT = OFF_BIG;
constexpr size_t OFF_PROJ = OFF_BIG;
constexpr size_t OFF_CQN = OFF_PROJ + 131923968;
constexpr size_t OFF_CKVN = OFF_CQN + 16777216;
constexpr size_t OFF_Q = OFF_CKVN + 8650752;
constexpr size_t OFF_K = OFF_Q + 50331648;
constexpr size_t OFF_V = OFF_K + 51904512;
constexpr size_t OFF_BAR = OFF_V + 34603008;
constexpr size_t OFF_XB = OFF_BAR + 16384;
constexpr size_t WS_END = OFF_XB + 67108864;

struct Params {
    const float *x, *c, *ctx, *c_ctx, *ada_w, *ada_b, *n1g, *f1in, *f1out, *n2g, *mixin, *rdf, *rdb, *qng, *wuq, *kvng, *wukv, *mixout, *n3g, *f2in, *f2out, *fng;
    float* out;
    unsigned char* ws;
};

__device__ __forceinline__ unsigned cvt_pk_bf16(float lo, float hi) { unsigned r; asm volatile("v_cvt_pk_bf16_f32 %0, %1, %2" : "=v"(r) : "v"(lo), "v"(hi)); return r; }
__device__ __forceinline__ float bflo(unsigned w) { return __uint_as_float(w << 16); }
__device__ __forceinline__ float bfhi(unsigned w) { return __uint_as_float(w & 0xffff0000u); }
__device__ __forceinline__ float bf2f(bf16_t b) { return __uint_as_float(((unsigned)b) << 16); }
__device__ __forceinline__ bf16_t f2bf(float f) { return (bf16_t)(cvt_pk_bf16(f, 0.f) & 0xffffu); }
__device__ __forceinline__ float silu_f(float g) { return g * __builtin_amdgcn_rcpf(1.0f + __expf(-g)); }
__device__ __forceinline__ int lane_id_v() { int l; asm volatile("v_mbcnt_lo_u32_b32 %0, -1, 0\n\tv_mbcnt_hi_u32_b32 %0, -1, %0" : "=v"(l)); return l; }
#define TIDX(wv) ((wv) * 64 + lane_id_v())
__device__ __forceinline__ float wave_sum(float v) {
#pragma unroll
    for (int o = 32; o >= 1; o >>= 1) v += __shfl_xor(v, o);
    return v;
}

namespace pg8 {
constexpr int BM = 256, BK = 64, HALF = 128, HTB = HALF * BK * 2, STAGE_BYTES = 8 * HTB, NXCD = 8, WGM = 8;
__host__ __device__ __forceinline__ int lds_byte(int r, int c) { const int st = (r >> 4) * 2 + (c >> 5), rr = r & 15, cc = c & 31, ob = rr * 64 + cc * 2; return st * 1024 + (ob ^ (((ob >> 9) & 1) << 5)); }
__host__ __device__ __forceinline__ void stage_rc(int b, int& R, int& C) { const int st = b / 1024, sb = b % 1024, swz = sb ^ (((sb >> 9) & 1) << 5); R = (st >> 1) * 16 + swz / 64; C = (st & 1) * 32 + (swz % 64) / 2; }
__host__ __device__ __forceinline__ int perm32(int rho) { const int n = rho >> 4, i = rho & 15; return 8 * (i >> 2) + 4 * n + (i & 3); }
struct Unit { int pm, pn; };
struct Gemm { const bf16_t* A; const bf16_t* Bt; int M, N, K, lda, ldb; };
struct StaticOrder {
    int nM, nN, nwg, G, c;
    __device__ void init(int M, int N, int G_, int c_) { nM = M / BM; nN = N / BM; nwg = nM * nN; G = G_; c = c_; }
    __device__ bool next(int i, Unit& u) const {
        const long L = (long)i * G + c; if (L >= nwg) return false;
        int wgid = (int)L; { const int q = nwg / NXCD, r = nwg % NXCD, xcd = wgid % NXCD, off = wgid / NXCD; wgid = (xcd < r ? xcd * (q + 1) : r * (q + 1) + (xcd - r) * q) + off; }
        const int nig = WGM * nN, gid = wgid / nig, fm = gid * WGM, gsz = (nM - fm) < WGM ? (nM - fm) : WGM;
        u.pm = fm + ((wgid % nig) % gsz); u.pn = (wgid % nig) / gsz; return true;
    }
    __device__ __forceinline__ size_t a_off(const Unit& u, size_t tA) const { return (size_t)u.pm * tA; }
    __device__ __forceinline__ size_t b_off(const Unit& u, size_t tB) const { return (size_t)u.pn * tB; }
};
template <int NP> struct SplitKOrder : StaticOrder {
    size_t ksb;
    __device__ __forceinline__ size_t a_off(const Unit& u, size_t tA) const { return (size_t)(u.pm % NP) * tA + (size_t)(u.pm / NP) * ksb; }
    __device__ __forceinline__ size_t b_off(const Unit& u, size_t tB) const { return (size_t)u.pn * tB + (size_t)(u.pm / NP) * ksb; }
};
template <class Epi, class Sched>
__device__ __forceinline__ void gemm_phase(LAS unsigned char* lds, const Gemm g, const Sched& S, const Epi& E, int wv) {
    const int lane = lane_id_v(), wid = wv, tid = wid * 64 + lane, wr = wid >> 2, wc = wid & 3, fr = lane & 15, fq = lane >> 4;
    const int K = g.K, nt = K / BK;
    unsigned voffA[2], voffB[2];
#pragma unroll
    for (int i = 0; i < 2; ++i) { int R, C; stage_rc(tid * 16 + i * 8192, R, C); const int Rb = Epi::PERM ? ((R & ~31) + perm32(R & 31)) : R;
        voffA[i] = (unsigned)(R * g.lda + C) * 2u; voffB[i] = (unsigned)(Rb * g.ldb + C) * 2u; }
    const size_t kstep = (size_t)(BK * 2);
    const size_t hA = (size_t)HALF * g.lda * 2, hB = (size_t)HALF * g.ldb * 2;
    const size_t tA = 2 * hA, tB = 2 * hB;
    const unsigned ldsw = (unsigned)wid * 1024u;
    const int aoff = lds_byte(wr * 64 + fr, fq * 8), boff = lds_byte(wc * 32 + fr, fq * 8);
#define PG8_SA(b, h) (((b) * 2 + (h)) * HTB)
#define PG8_SB(b, h) ((4 + (b) * 2 + (h)) * HTB)
#define PG8_STAGE(bufoff, gbase, voff) do { _Pragma("unroll") for (int _i = 0; _i < 2; ++_i) \
        __builtin_amdgcn_global_load_lds((const unsigned*)((const char*)(gbase) + (voff)[_i]), (LAS unsigned*)(lds + (bufoff) + ldsw + _i * 8192), 16, 0, 0); } while (0)
#define PG8_LDA(dst, b, h) do { _Pragma("unroll") for (int m = 0; m < 4; ++m) _Pragma("unroll") for (int k = 0; k < 2; ++k) dst[m][k] = *(const LAS bf16x8*)(lds + PG8_SA(b, h) + aoff + m * 2048 + k * 1024); } while (0)
#define PG8_LDB(dst, b, h) do { _Pragma("unroll") for (int n = 0; n < 2; ++n) _Pragma("unroll") for (int k = 0; k < 2; ++k) dst[n][k] = *(const LAS bf16x8*)(lds + PG8_SB(b, h) + boff + n * 2048 + k * 1024); } while (0)
#define PG8_MMA(ai, bj, At, Bt) do { __builtin_amdgcn_s_setprio(1); _Pragma("unroll") for (int m = 0; m < 4; ++m) _Pragma("unroll") for (int n = 0; n < 2; ++n) _Pragma("unroll") for (int k = 0; k < 2; ++k) \
        acc[ai][bj][m][n] = __builtin_amdgcn_mfma_f32_16x16x32_bf16(Bt[n][k], At[m][k], acc[ai][bj][m][n], 0, 0, 0); __builtin_amdgcn_s_setprio(0); } while (0)
#define PG8_WAIT_V(n) asm volatile("s_waitcnt vmcnt(" #n ")" ::: "memory")
#define PG8_WAIT_L(n) asm volatile("s_waitcnt lgkmcnt(" #n ")" ::: "memory")
#define PG8_BAR __builtin_amdgcn_s_barrier()
#define PG8_SCHED __builtin_amdgcn_sched_barrier(0)
    Unit cur, nxt; int ui = 0;
    if (!S.next(0, cur)) return;
    f32x4 acc[2][2][4][2];
#pragma unroll
    for (int a = 0; a < 2; ++a)
#pragma unroll
        for (int b = 0; b < 2; ++b)
#pragma unroll
            for (int m = 0; m < 4; ++m)
#pragma unroll
                for (int n = 0; n < 2; ++n) acc[a][b][m][n] = (f32x4){0.f, 0.f, 0.f, 0.f};
    bf16x8 At[4][2], B0[2][2], B1[2][2];
    const char* cA = (const char*)g.A + S.a_off(cur, tA); const char* cB = (const char*)g.Bt + S.b_off(cur, tB);
    PG8_STAGE(PG8_SB(0, 0), cB, voffB); PG8_STAGE(PG8_SA(0, 0), cA, voffA); PG8_STAGE(PG8_SB(0, 1), cB + hB, voffB); PG8_STAGE(PG8_SA(0, 1), cA + hA, voffA);
    if (wr == 1) PG8_BAR;
    PG8_WAIT_V(4); PG8_BAR;
    PG8_STAGE(PG8_SB(1, 0), cB + kstep, voffB); PG8_STAGE(PG8_SA(1, 0), cA + kstep, voffA); PG8_STAGE(PG8_SB(1, 1), cB + hB + kstep, voffB);
    PG8_WAIT_V(6); PG8_BAR;
    for (;;) {
        const bool has_next = S.next(ui + 1, nxt);
        const char* nA = has_next ? (const char*)g.A + S.a_off(nxt, tA) : cA; const char* nB = has_next ? (const char*)g.Bt + S.b_off(nxt, tB) : cB;
        for (int t = 0; t < nt; t += 2) {
            const bool last = (t == nt - 2);
            const char* a1 = cA + (size_t)(t + 1) * kstep;
            const char* a2 = last ? nA : cA + (size_t)(t + 2) * kstep; const char* b2 = last ? nB : cB + (size_t)(t + 2) * kstep;
            const char* a3 = a2 + kstep; const char* b3 = b2 + kstep;
            PG8_LDB(B0, 0, 0); PG8_SCHED; PG8_LDA(At, 0, 0); PG8_STAGE(PG8_SA(1, 1), a1 + hA, voffA);
            PG8_WAIT_L(8); PG8_BAR; PG8_WAIT_L(0); PG8_MMA(0, 0, At, B0); PG8_BAR; PG8_SCHED;
            PG8_LDB(B1, 0, 1); PG8_STAGE(PG8_SB(0, 0), b2, voffB);
            PG8_BAR; PG8_WAIT_L(0); PG8_MMA(0, 1, At, B1); PG8_BAR;
            PG8_LDA(At, 0, 1); PG8_STAGE(PG8_SA(0, 0), a2, voffA);
            PG8_BAR; PG8_WAIT_L(0); PG8_MMA(1, 0, At, B0); PG8_BAR; PG8_SCHED;
            PG8_STAGE(PG8_SB(0, 1), b2 + hB, voffB);
            PG8_WAIT_V(6); PG8_BAR; PG8_MMA(1, 1, At, B1); PG8_BAR;
            PG8_LDB(B0, 1, 0); PG8_SCHED; PG8_LDA(At, 1, 0); PG8_STAGE(PG8_SA(0, 1), a2 + hA, voffA);
            PG8_WAIT_L(8); PG8_BAR; PG8_WAIT_L(0); PG8_MMA(0, 0, At, B0); PG8_BAR; PG8_SCHED;
            PG8_LDB(B1, 1, 1); PG8_STAGE(PG8_SB(1, 0), b3, voffB);
            PG8_BAR; PG8_WAIT_L(0); PG8_MMA(0, 1, At, B1); PG8_BAR;
            PG8_LDA(At, 1, 1); PG8_STAGE(PG8_SA(1, 0), a3, voffA);
            PG8_BAR; PG8_WAIT_L(0); PG8_MMA(1, 0, At, B0); PG8_BAR; PG8_SCHED;
            PG8_STAGE(PG8_SB(1, 1), b3 + hB, voffB);
            PG8_WAIT_V(6); PG8_BAR; PG8_MMA(1, 1, At, B1); PG8_BAR;
        }
        E(acc, cur, wr, wc, fr, fq);
        if (!has_next) break;
#pragma unroll
        for (int a = 0; a < 2; ++a)
#pragma unroll
            for (int b = 0; b < 2; ++b)
#pragma unroll
                for (int m = 0; m < 4; ++m)
#pragma unroll
                    for (int n = 0; n < 2; ++n) acc[a][b][m][n] = (f32x4){0.f, 0.f, 0.f, 0.f};
        cur = nxt; cA = nA; cB = nB; ++ui;
    }
    PG8_WAIT_V(0);
    if (wr == 0) PG8_BAR;
    PG8_BAR;
#undef PG8_SA
#undef PG8_SB
#undef PG8_STAGE
#undef PG8_LDA
#undef PG8_LDB
#undef PG8_MMA
#undef PG8_WAIT_V
#undef PG8_WAIT_L
#undef PG8_BAR
#undef PG8_SCHED
}
}

typedef f32x4 AccT[2][2][4][2];
struct EpiSwiglu {
    static constexpr bool PERM = true;
    bf16_t* O;
    __device__ __forceinline__ void operator()(const AccT& acc, const pg8::Unit& u, int wr, int wc, int fr, int fq) const {
        const int row0 = u.pm * 256 + wr * 64 + fr, col0 = u.pn * 128 + wc * 32 + 8 * fq;
#pragma unroll
        for (int ai = 0; ai < 2; ++ai)
#pragma unroll
            for (int m = 0; m < 4; ++m) {
                bf16_t* rowp = O + (size_t)(row0 + ai * 128 + m * 16) * DFF + col0;
                const f32x4 g0 = acc[ai][0][m][0], g1 = acc[ai][0][m][1], u0 = acc[ai][1][m][0], u1 = acc[ai][1][m][1];
                u32x4 w;
                w.x = cvt_pk_bf16(silu_f(g0[0]) * u0[0], silu_f(g0[1]) * u0[1]); w.y = cvt_pk_bf16(silu_f(g0[2]) * u0[2], silu_f(g0[3]) * u0[3]);
                w.z = cvt_pk_bf16(silu_f(g1[0]) * u1[0], silu_f(g1[1]) * u1[1]); w.w = cvt_pk_bf16(silu_f(g1[2]) * u1[2], silu_f(g1[3]) * u1[3]);
                *(u32x4*)rowp = w;
            }
    }
};
struct EpiResid {
    static constexpr bool PERM = false;
    const float* baseLat; const float* baseCtx; float* outLat; float* outCtx; const float* mod; int gidx; float coef;
    __device__ __forceinline__ void operator()(const AccT& acc, const pg8::Unit& u, int wr, int wc, int fr, int fq) const {
        const bool lat = u.pm < 64; const int grp = lat ? (u.pm >> 5) : 2;
        const float* base = lat ? baseLat : baseCtx; float* out = lat ? outLat : outCtx;
        const int row0 = (lat ? u.pm : u.pm - 64) * 256 + wr * 64 + fr, col0 = u.pn * 256 + wc * 32 + 4 * fq;
        const float* gp = mod + (size_t)(grp * 9 + gidx) * DM + col0;
        f32x4 gv[2][2];
#pragma unroll
        for (int bj = 0; bj < 2; ++bj)
#pragma unroll
            for (int n = 0; n < 2; ++n) gv[bj][n] = *(const f32x4*)(gp + bj * 128 + n * 16) * coef;
#pragma unroll
        for (int ai = 0; ai < 2; ++ai)
#pragma unroll
            for (int m = 0; m < 4; ++m) {
                const size_t off = (size_t)(row0 + ai * 128 + m * 16) * DM + col0;
#pragma unroll
                for (int bj = 0; bj < 2; ++bj)
#pragma unroll
                    for (int n = 0; n < 2; ++n) {
                        const f32x4 b = *(const f32x4*)(base + off + bj * 128 + n * 16);
                        *(f32x4*)(out + off + bj * 128 + n * 16) = b + gv[bj][n] * acc[ai][bj][m][n];
                    }
            }
    }
};
template <bool BASE_F32, bool OUT_F32> struct EpiResidB {
    static constexpr bool PERM = true;
    const float* basef; const bf16_t* baseb; float* outf; bf16_t* outb; const float* mod; int gidx; float coef;
    __device__ __forceinline__ void operator()(const AccT& acc, const pg8::Unit& u, int wr, int wc, int fr, int fq) const {
        const int grp = u.pm >> 5;
        const int row0 = u.pm * 256 + wr * 64 + fr, col0 = u.pn * 256 + wc * 32 + 8 * fq;
        const float* gp = mod + (size_t)(grp * 9 + gidx) * DM + col0;
        f32x4 gv[2][2];
#pragma unroll
        for (int bj = 0; bj < 2; ++bj)
#pragma unroll
            for (int n = 0; n < 2; ++n) gv[bj][n] = *(const f32x4*)(gp + bj * 128 + n * 4) * coef;
#pragma unroll
        for (int ai = 0; ai < 2; ++ai)
#pragma unroll
            for (int m = 0; m < 4; ++m) {
                const size_t off = (size_t)(row0 + ai * 128 + m * 16) * DM + col0;
#pragma unroll
                for (int bj = 0; bj < 2; ++bj) {
                    f32x4 b0, b1;
                    if (BASE_F32) { b0 = *(const f32x4*)(basef + off + bj * 128); b1 = *(const f32x4*)(basef + off + bj * 128 + 4); }
                    else { const u32x4 w = *(const u32x4*)(baseb + off + bj * 128); b0 = (f32x4){bflo(w.x), bfhi(w.x), bflo(w.y), bfhi(w.y)}; b1 = (f32x4){bflo(w.z), bfhi(w.z), bflo(w.w), bfhi(w.w)}; }
                    const f32x4 x0 = b0 + gv[bj][0] * acc[ai][bj][m][0], x1 = b1 + gv[bj][1] * acc[ai][bj][m][1];
                    if (OUT_F32) { *(f32x4*)(outf + off + bj * 128) = x0; *(f32x4*)(outf + off + bj * 128 + 4) = x1; }
                    else { u32x4 w; w.x = cvt_pk_bf16(x0[0], x0[1]); w.y = cvt_pk_bf16(x0[2], x0[3]); w.z = cvt_pk_bf16(x1[0], x1[1]); w.w = cvt_pk_bf16(x1[2], x1[3]); *(u32x4*)(outb + off + bj * 128) = w; }
                }
            }
    }
};
struct EpiKrPart {
    static constexpr bool PERM = false;
    float* part;
    __device__ __forceinline__ void operator()(const AccT& acc, const pg8::Unit& u, int wr, int wc, int fr, int fq) const {
        if (wc >= 2) return;
        const int ks = u.pm / 66, panel = u.pm % 66;
        const int row0 = panel * 256 + wr * 64 + fr, col0 = wc * 32 + 4 * fq;
#pragma unroll
        for (int ai = 0; ai < 2; ++ai)
#pragma unroll
            for (int m = 0; m < 4; ++m) {
                float* rowp = part + ((size_t)ks * MALL + row0 + ai * 128 + m * 16) * 64 + col0;
                *(f32x4*)(rowp) = acc[ai][0][m][0]; *(f32x4*)(rowp + 16) = acc[ai][0][m][1];
            }
    }
};
struct EpiPartial {
    static constexpr bool PERM = false;
    float* part;
    __device__ __forceinline__ void operator()(const AccT& acc, const pg8::Unit& u, int wr, int wc, int fr, int fq) const {
        const int row0 = u.pm * 256 + wr * 64 + fr, col0 = u.pn * 256 + wc * 32 + 4 * fq;
#pragma unroll
        for (int ai = 0; ai < 2; ++ai)
#pragma unroll
            for (int m = 0; m < 4; ++m) {
                float* rowp = part + (size_t)(row0 + ai * 128 + m * 16) * DM + col0;
#pragma unroll
                for (int bj = 0; bj < 2; ++bj)
#pragma unroll
                    for (int n = 0; n < 2; ++n) *(f32x4*)(rowp + bj * 128 + n * 16) = acc[ai][bj][m][n];
            }
    }
};
struct EpiProj {
    static constexpr bool PERM = true;
    bf16_t* O; const float* rcos; const float* rsin;
    __device__ __forceinline__ void operator()(const AccT& acc, const pg8::Unit& u, int wr, int wc, int fr, int fq) const {
        const int row0 = u.pm * 256 + wr * 64 + fr, col0 = u.pn * 256 + wc * 32 + 8 * fq;
        if (u.pn < 4) {
            const float sc = (u.pn >= 2) ? 0.125f : 1.0f;
            const bool lat = u.pm < 64;
            const int f = (wc & 1) * 16 + 4 * fq;
#pragma unroll
            for (int ai = 0; ai < 2; ++ai)
#pragma unroll
                for (int m = 0; m < 4; ++m) {
                    const int r = row0 + ai * 128 + m * 16;
                    f32x4 cs = {1.f, 1.f, 1.f, 1.f}, sn = {0.f, 0.f, 0.f, 0.f};
                    if (lat) { const int t = r & 8191; cs = *(const f32x4*)(rcos + (size_t)t * 32 + f); sn = *(const f32x4*)(rsin + (size_t)t * 32 + f); }
                    bf16_t* rowp = O + (size_t)r * PROJ_LD;
#pragma unroll
                    for (int bj = 0; bj < 2; ++bj) {
                        const int head0 = ((u.pn * 256 + bj * 128 + wc * 32) >> 6) << 6;
                        const f32x4 x1 = acc[ai][bj][m][0], x2 = acc[ai][bj][m][1];
                        const f32x4 o1 = (x1 * cs - x2 * sn) * sc, o2 = (x2 * cs + x1 * sn) * sc;
                        u32x2 a, b; a.x = cvt_pk_bf16(o1[0], o1[1]); a.y = cvt_pk_bf16(o1[2], o1[3]); b.x = cvt_pk_bf16(o2[0], o2[1]); b.y = cvt_pk_bf16(o2[2], o2[3]);
                        *(u32x2*)(rowp + head0 + f) = a; *(u32x2*)(rowp + head0 + 32 + f) = b;
                    }
                }
            return;
        }
#pragma unroll
        for (int ai = 0; ai < 2; ++ai)
#pragma unroll
            for (int m = 0; m < 4; ++m) {
                bf16_t* rowp = O + (size_t)(row0 + ai * 128 + m * 16) * PROJ_LD;
#pragma unroll
                for (int bj = 0; bj < 2; ++bj) {
                    const int c = col0 + bj * 128;
                    if (c < PROJ_LD) {
                        const f32x4 v0 = acc[ai][bj][m][0], v1 = acc[ai][bj][m][1];
                        u32x4 w; w.x = cvt_pk_bf16(v0[0], v0[1]); w.y = cvt_pk_bf16(v0[2], v0[3]); w.z = cvt_pk_bf16(v1[0], v1[1]); w.w = cvt_pk_bf16(v1[2], v1[3]);
                        *(u32x4*)(rowp + c) = w;
                    }
                }
            }
    }
};
struct EpiQ {
    static constexpr bool PERM = false;
    bf16_t* Q; const float* axc; const float* axs;
    __device__ __forceinline__ void operator()(const AccT& acc, const pg8::Unit& u, int wr, int wc, int fr, int fq) const {
        const int row0 = u.pm * 256 + wr * 64 + fr;
#pragma unroll
        for (int bj = 0; bj < 2; ++bj) {
            const int grp32 = 8 * u.pn + 4 * bj + wc; const int w6 = grp32 % 6; const bool rope = w6 >= 4; const int part = w6 - 4;
            const int col = grp32 * 32 + 4 * fq;
#pragma unroll
            for (int ai = 0; ai < 2; ++ai)
#pragma unroll
                for (int m = 0; m < 4; ++m) {
                    const int r = row0 + ai * 128 + m * 16; const int t = r & 8191; const int pos = (part == 0) ? (t >> 6) : (t & 63);
                    f32x4 x1 = acc[ai][bj][m][0], x2 = acc[ai][bj][m][1];
                    if (rope) {
                        const f32x4 cs = *(const f32x4*)(axc + pos * 16 + 4 * fq), sn = *(const f32x4*)(axs + pos * 16 + 4 * fq);
                        const f32x4 o1 = x1 * cs - x2 * sn, o2 = x2 * cs + x1 * sn; x1 = o1; x2 = o2;
                    }
                    bf16_t* rowp = Q + (size_t)r * 1536 + col;
                    u32x2 a, b; a.x = cvt_pk_bf16(x1[0], x1[1]); a.y = cvt_pk_bf16(x1[2], x1[3]); b.x = cvt_pk_bf16(x2[0], x2[1]); b.y = cvt_pk_bf16(x2[2], x2[3]);
                    *(u32x2*)rowp = a; *(u32x2*)(rowp + 16) = b;
                }
        }
    }
};
struct EpiKV {
    static constexpr bool PERM = true;
    bf16_t* Kd; bf16_t* Vd; int pm0;
    __device__ __forceinline__ void operator()(const AccT& acc, const pg8::Unit& u, int wr, int wc, int fr, int fq) const {
        const int pmg = u.pm + pm0; const bool lat = pmg < 64; const int b = lat ? (pmg >> 5) : (pmg - 64); const int key0 = lat ? (pmg & 31) * 256 : 8192;
        const int e0 = wc * 32 + 8 * fq; const size_t bh = (size_t)(b * 8 + u.pn) * SKV;
#pragma unroll
        for (int ai = 0; ai < 2; ++ai)
#pragma unroll
            for (int m = 0; m < 4; ++m) {
                const size_t key = bh + key0 + ai * 128 + wr * 64 + m * 16 + fr;
                { const f32x4 v0 = acc[ai][0][m][0], v1 = acc[ai][0][m][1]; u32x4 w; w.x = cvt_pk_bf16(v0[0], v0[1]); w.y = cvt_pk_bf16(v0[2], v0[3]); w.z = cvt_pk_bf16(v1[0], v1[1]); w.w = cvt_pk_bf16(v1[2], v1[3]);
                  *(u32x4*)(Kd + key * 192 + e0) = w; }
                { const f32x4 v0 = acc[ai][1][m][0], v1 = acc[ai][1][m][1]; u32x4 w; w.x = cvt_pk_bf16(v0[0], v0[1]); w.y = cvt_pk_bf16(v0[2], v0[3]); w.z = cvt_pk_bf16(v1[0], v1[1]); w.w = cvt_pk_bf16(v1[2], v1[3]);
                  *(u32x4*)(Vd + key * 128 + e0) = w; }
            }
    }
};

template <class Epi>
__device__ __forceinline__ void run_gemm(unsigned char* shm, const bf16_t* A, const bf16_t* Bt, int M, int N, int K, const Epi& E, int wv, int cblk = -1, int lda = 0, int ldb = 0) {
    __syncthreads();
    pg8::Gemm g; g.A = A; g.Bt = Bt; g.M = M; g.N = N; g.K = K; g.lda = lda ? lda : K; g.ldb = ldb ? ldb : K;
    pg8::StaticOrder S; S.init(M, N, (int)gridDim.x, cblk < 0 ? (int)blockIdx.x : cblk);
    pg8::gemm_phase<Epi, pg8::StaticOrder>((LAS unsigned char*)shm, g, S, E, wv);
    __syncthreads();
}
template <class Epi, int NP>
__device__ __forceinline__ void run_gemm_splitk(unsigned char* shm, const bf16_t* A, const bf16_t* Bt, int N, int K, int KS, const Epi& E, int wv, int ld = 0, int cblk = -1) {
    __syncthreads();
    pg8::Gemm g; g.A = A; g.Bt = Bt; g.M = NP * 256 * KS; g.N = N; g.K = K / KS; g.lda = ld ? ld : K; g.ldb = ld ? ld : K;
    pg8::SplitKOrder<NP> S; S.init(g.M, N, (int)gridDim.x, cblk < 0 ? (int)blockIdx.x : cblk); S.ksb = (size_t)(K / KS) * 2;
    pg8::gemm_phase<Epi, pg8::SplitKOrder<NP>>((LAS unsigned char*)shm, g, S, E, wv);
    __syncthreads();
}

namespace att {
constexpr int QBLK = 32, KVBLK = 64, LDQ = 1536, LDO = LDH;
constexpr float SCALE = 0.07216878364870323f;
constexpr float THR = 8.f;
constexpr int SHM_V = 64 * 128 * 2, SHM_K = 64 * 192 * 2;
#ifndef ATT_NQR
#define ATT_NQR 12
#endif
constexpr int NQR = ATT_NQR;
#define KSWZ(row, colB) ((row) * 384 + ((colB) ^ ((((row) >> 1) & 7) << 4)))
#define SBAR() __builtin_amdgcn_sched_barrier(0)
__device__ __forceinline__ int crow(int r, int hi) { return (r & 3) + 8 * (r >> 2) + 4 * hi; }
__device__ __forceinline__ void partialSM(f32x16& p0, f32x16& p1, float& m_reg, float& mn, float& alpha) {
    constexpr float C = SCALE * 1.4426950408889634f;
    float pmax = p0[0];
#pragma unroll
    for (int r = 1; r < 16; ++r) pmax = fmaxf(pmax, p0[r]);
#pragma unroll
    for (int r = 0; r < 16; ++r) pmax = fmaxf(pmax, p1[r]);
    { auto rr = __builtin_amdgcn_permlane32_swap(__float_as_uint(pmax), __float_as_uint(pmax), false, false);
      pmax = fmaxf(__uint_as_float(rr[0]), __uint_as_float(rr[1])); }
    if (__builtin_expect(__all(pmax - m_reg <= THR / SCALE), 1)) { mn = m_reg; alpha = 1.f; }
    else { mn = fmaxf(m_reg, pmax); alpha = __builtin_amdgcn_exp2f((m_reg - mn) * C); m_reg = mn; }
    const float mnC = -mn * C;
#pragma unroll
    for (int r = 0; r < 16; ++r) p0[r] = fmaf(p0[r], C, mnC);
#pragma unroll
    for (int r = 0; r < 16; ++r) p1[r] = fmaf(p1[r], C, mnC);
#pragma unroll
    for (int r = 0; r < 16; ++r) p0[r] = __builtin_amdgcn_exp2f(p0[r]);
}
__device__ __forceinline__ void finishSM(f32x16& p0, f32x16& p1, float alpha, float& l_reg, bf16x8& pa0, bf16x8& pa1, bf16x8& pa2, bf16x8& pa3) {
#pragma unroll
    for (int r = 0; r < 16; ++r) p1[r] = __builtin_amdgcn_exp2f(p1[r]);
    float ps = 0;
#pragma unroll
    for (int r = 0; r < 16; ++r) ps += p0[r];
#pragma unroll
    for (int r = 0; r < 16; ++r) ps += p1[r];
    { auto rr = __builtin_amdgcn_permlane32_swap(__float_as_uint(ps), __float_as_uint(ps), false, false);
      ps = __uint_as_float(rr[0]) + __uint_as_float(rr[1]); }
    l_reg = l_reg * alpha + ps;
#define PK4(P, BASE, OUT) do { unsigned a0 = cvt_pk_bf16(P[BASE + 0], P[BASE + 1]), a1 = cvt_pk_bf16(P[BASE + 2], P[BASE + 3]);   \
    unsigned b0 = cvt_pk_bf16(P[BASE + 4], P[BASE + 5]), b1 = cvt_pk_bf16(P[BASE + 6], P[BASE + 7]);                              \
    auto r0 = __builtin_amdgcn_permlane32_swap(a0, b0, false, false); auto r1 = __builtin_amdgcn_permlane32_swap(a1, b1, false, false); \
    u32x4 w = {r0[0], r1[0], r0[1], r1[1]}; OUT = *reinterpret_cast<bf16x8*>(&w); } while (0)
    PK4(p0, 0, pa0); PK4(p0, 8, pa1); PK4(p1, 0, pa2); PK4(p1, 8, pa3);
#undef PK4
}
__device__ __forceinline__ void qkt(f32x16& p0, f32x16& p1, const char* Ks, const bf16x8* qr, const char* qro, int r32, int hi) {
    p0 = f32x16{}; p1 = f32x16{};
#pragma unroll
    for (int d0 = 0; d0 < 12; ++d0) { const int cb = (d0 * 16 + hi * 8) * 2;
        const bf16x8 b0 = *reinterpret_cast<const bf16x8*>(Ks + KSWZ(r32, cb));
        const bf16x8 b1 = *reinterpret_cast<const bf16x8*>(Ks + KSWZ(32 + r32, cb));
        const bf16x8 qv = d0 < NQR ? qr[d0 < NQR ? d0 : 0] : *reinterpret_cast<const bf16x8*>(qro + (d0 - NQR) * 1024);
        p0 = __builtin_amdgcn_mfma_f32_32x32x16_bf16(b0, qv, p0, 0, 0, 0);
        p1 = __builtin_amdgcn_mfma_f32_32x32x16_bf16(b1, qv, p1, 0, 0, 0); }
}
__device__ __forceinline__ int v_st(int k, int c) { const int kk = (k & ~0xC) | ((k & 4) << 1) | ((k & 8) >> 1); return ((kk >> 3) * 4 + (c >> 5)) * 512 + ((kk & 7) * 32 + (c & 31)) * 2; }
__device__ __forceinline__ int v_rd_base(int lane) { return ((lane & 3) << 3) | (((lane >> 2) & 3) << 6) | (((lane >> 4) & 1) << 5) | (((lane >> 5) & 1) << 8); }
constexpr int v_rd_off(int d0, int ks, int half) { return d0 * 512 + ks * 4096 + half * 2048; }
template <int OFF> __device__ __forceinline__ s16x4 tr_read(int vb) {
    s16x4 r; asm volatile("ds_read_b64_tr_b16 %0, %1 offset:%2" : "=&v"(r) : "v"(vb), "i"(OFF) : "memory"); return r;
}
template <int D0> __device__ __forceinline__ void pv_one(f32x16& od, int vb, bf16x8 pa0, bf16x8 pa1, bf16x8 pa2, bf16x8 pa3) {
    const s16x4 l0 = tr_read<v_rd_off(D0, 0, 0)>(vb), h0 = tr_read<v_rd_off(D0, 0, 1)>(vb), l1 = tr_read<v_rd_off(D0, 1, 0)>(vb), h1 = tr_read<v_rd_off(D0, 1, 1)>(vb);
    const s16x4 l2 = tr_read<v_rd_off(D0, 2, 0)>(vb), h2 = tr_read<v_rd_off(D0, 2, 1)>(vb), l3 = tr_read<v_rd_off(D0, 3, 0)>(vb), h3 = tr_read<v_rd_off(D0, 3, 1)>(vb);
    asm volatile("s_waitcnt lgkmcnt(0)" ::: "memory"); SBAR();
#define PK(L, H) (bf16x8){L[0], L[1], L[2], L[3], H[0], H[1], H[2], H[3]}
    od = __builtin_amdgcn_mfma_f32_32x32x16_bf16(pa0, PK(l0, h0), od, 0, 0, 0);
    od = __builtin_amdgcn_mfma_f32_32x32x16_bf16(pa1, PK(l1, h1), od, 0, 0, 0);
    od = __builtin_amdgcn_mfma_f32_32x32x16_bf16(pa2, PK(l2, h2), od, 0, 0, 0);
    od = __builtin_amdgcn_mfma_f32_32x32x16_bf16(pa3, PK(l3, h3), od, 0, 0, 0);
#undef PK
}
__device__ __forceinline__ void pv_d0(f32x16* o, int vb, bf16x8 pa0, bf16x8 pa1, bf16x8 pa2, bf16x8 pa3) {
    pv_one<0>(o[0], vb, pa0, pa1, pa2, pa3); pv_one<1>(o[1], vb, pa0, pa1, pa2, pa3); pv_one<2>(o[2], vb, pa0, pa1, pa2, pa3); pv_one<3>(o[3], vb, pa0, pa1, pa2, pa3);
}
__device__ __forceinline__ void attn_body(const bf16_t* __restrict__ Qb, const bf16_t* __restrict__ Kh, const bf16_t* __restrict__ Vh, bf16_t* __restrict__ Ob, int seq, char* lds, int wv) {
    const int lane = lane_id_v(), wid = wv, r32 = lane & 31, hi = lane >> 5;
    char* V_lds = lds; char* K_lds = lds + 2 * SHM_V;
    float* ws = (float*)(lds + 2 * SHM_V + 2 * SHM_K) + wid * 64; float* li_l = ws; float* al_l = ws + 32;
    float m_reg = -1e30f, l_reg = 0; f32x16 o[4] = {}; bf16x8 qr[NQR];
    const bf16_t* Qw = Qb + (long)(wid * QBLK + r32) * LDQ + hi * 8;
    char* qro = lds + 2 * SHM_V + 2 * SHM_K + 2048 + wid * ((12 - NQR) * 1024) + lane * 16;
#pragma unroll
    for (int d0 = 0; d0 < NQR; ++d0) qr[d0] = *reinterpret_cast<const bf16x8*>(Qw + d0 * 16);
#pragma unroll
    for (int d0 = NQR; d0 < 12; ++d0) *reinterpret_cast<bf16x8*>(qro + (d0 - NQR) * 1024) = *reinterpret_cast<const bf16x8*>(Qw + d0 * 16);
    const int wu = wv;
    unsigned ksrc[3], vsrc[2];
#pragma unroll
    for (int i = 0; i < 3; ++i) { const int pp = (i * 8 + wid) * 64 + lane, row = pp / 24, cpos = pp - row * 24, c = (cpos & ~7) | ((cpos ^ (row >> 1)) & 7); ksrc[i] = (unsigned)(row * 192 + c * 8) * 2u; }
#pragma unroll
    for (int i = 0; i < 2; ++i) { const int pp = (i * 8 + wid) * 64 + lane, kk = (pp >> 7) * 8 + ((pp & 31) >> 2), k = (kk & ~0xC) | ((kk & 4) << 1) | ((kk & 8) >> 1), c = ((pp >> 5) & 3) * 32 + (pp & 3) * 8;
        vsrc[i] = (unsigned)(k * 128 + c) * 2u; }
    LAS unsigned char* ldsl = (LAS unsigned char*)lds;
    const int vb0 = (int)(uintptr_t)V_lds + v_rd_base(lane);
#define DMA_K(k0, b) do { const char* kb_ = (const char*)Kh + (size_t)(k0) * 384; _Pragma("unroll") for (int i_ = 0; i_ < 3; ++i_) \
    __builtin_amdgcn_global_load_lds((const unsigned*)(kb_ + ksrc[i_]), (LAS unsigned*)(ldsl + 2 * SHM_V + (b) * SHM_K + (i_ * 8 + wu) * 1024), 16, 0, 0); } while (0)
#define DMA_V(k0, b) do { const char* vb_ = (const char*)Vh + (size_t)(k0) * 256; _Pragma("unroll") for (int i_ = 0; i_ < 2; ++i_) \
    __builtin_amdgcn_global_load_lds((const unsigned*)(vb_ + vsrc[i_]), (LAS unsigned*)(ldsl + (b) * SHM_V + (i_ * 8 + wu) * 1024), 16, 0, 0); } while (0)
#define ABAR1() do { asm volatile("s_waitcnt lgkmcnt(0)" ::: "memory"); __builtin_amdgcn_s_barrier(); asm volatile("" ::: "memory"); } while (0)
#define ABAR2(n) do { asm volatile("s_waitcnt vmcnt(" #n ") lgkmcnt(0)" ::: "memory"); __builtin_amdgcn_s_barrier(); asm volatile("" ::: "memory"); } while (0)
#define RESC(a) do { if (__any((a) < 1.f)) { if (hi == 0) al_l[r32] = (a); asm volatile("s_waitcnt lgkmcnt(0)" ::: "memory"); \
    _Pragma("unroll") for (int d = 0; d < 4; ++d) _Pragma("unroll") for (int r = 0; r < 16; ++r) o[d][r] *= al_l[crow(r, hi)]; } } while (0)
    f32x16 pA0, pA1, pB0, pB1; float mnA, mnB, alA, alB; bf16x8 pa0, pa1, pa2, pa3; const int NT = seq / KVBLK;
    DMA_K(0, 0); DMA_V(0, 0); ABAR2(0);
    DMA_K(KVBLK, 1);
    qkt(pA0, pA1, K_lds, qr, qro, r32, hi); partialSM(pA0, pA1, m_reg, mnA, alA);
    DMA_V(KVBLK, 1);
    ABAR2(2);
    for (int j = 1; j + 1 < NT; j += 2) {
        DMA_K((j + 1) * KVBLK, 0);
        SBAR(); qkt(pB0, pB1, K_lds + SHM_K, qr, qro, r32, hi);
        finishSM(pA0, pA1, alA, l_reg, pa0, pa1, pa2, pa3); SBAR();
        pv_d0(o, vb0, pa0, pa1, pa2, pa3); partialSM(pB0, pB1, m_reg, mnB, alB);
        ABAR1(); DMA_V((j + 1) * KVBLK, 0);
        RESC(alB); ABAR2(2);
        DMA_K((j + 2) * KVBLK, 1);
        SBAR(); qkt(pA0, pA1, K_lds, qr, qro, r32, hi);
        finishSM(pB0, pB1, alB, l_reg, pa0, pa1, pa2, pa3); SBAR();
        pv_d0(o, vb0 + SHM_V, pa0, pa1, pa2, pa3); partialSM(pA0, pA1, m_reg, mnA, alA);
        ABAR1(); DMA_V((j + 2) * KVBLK, 1);
        RESC(alA); ABAR2(2);
    }
    SBAR(); qkt(pB0, pB1, K_lds + SHM_K, qr, qro, r32, hi);
    finishSM(pA0, pA1, alA, l_reg, pa0, pa1, pa2, pa3); SBAR();
    pv_d0(o, vb0, pa0, pa1, pa2, pa3); partialSM(pB0, pB1, m_reg, mnB, alB);
    ABAR2(0); RESC(alB);
    finishSM(pB0, pB1, alB, l_reg, pa0, pa1, pa2, pa3); SBAR();
    pv_d0(o, vb0 + SHM_V, pa0, pa1, pa2, pa3);
    if (hi == 0) li_l[r32] = l_reg; asm volatile("s_waitcnt lgkmcnt(0)" ::: "memory");
    float rli[16];
#pragma unroll
    for (int r = 0; r < 16; ++r) rli[r] = __builtin_amdgcn_rcpf(li_l[crow(r, hi)]);
    bf16_t* Ow = Ob + (long)(wid * QBLK) * LDO;
#pragma unroll
    for (int r = 0; r < 16; ++r) { const int orow = crow(r, hi);
#pragma unroll
        for (int d0 = 0; d0 < 4; ++d0) Ow[(long)orow * LDO + d0 * 32 + r32] = f2bf(o[d0][r] * rli[r]); }
#undef DMA_K
#undef DMA_V
#undef ABAR1
#undef ABAR2
#undef RESC
}
}

__device__ __forceinline__ void convert_w(const float* __restrict__ src, bf16_t* __restrict__ dst, int K, int N, int mode, unsigned char* shm, int wv, int t0, int tstride, int ldk = 0) {
    if (ldk == 0) ldk = K;
    float* tile = (float*)shm;
    const int tid = TIDX(wv), nkg = K >> 8, nnt = N >> 6, total = nkg * nnt;
    f32x4 v[8];
#define CW_LOAD(T) do { const int kg_ = (T) % nkg, nt_ = (T) / nkg; _Pragma("unroll") for (int i = 0; i < 8; ++i) { const int r = (tid >> 4) + 32 * i, c4 = (tid & 15) * 4; \
        v[i] = __builtin_nontemporal_load((const f32x4*)(src + (size_t)(kg_ * 256 + r) * N + nt_ * 64 + c4)); } } while (0)
    if (t0 < total) CW_LOAD(t0);
    for (int t = t0; t < total; t += tstride) {
        const int kg = t % nkg, ntile = t / nkg;
#pragma unroll
        for (int i = 0; i < 8; ++i) {
            const int r = (tid >> 4) + 32 * i, c4 = (tid & 15) * 4;
            float* tp = tile + (r >> 6) * (64 * 65) + (r & 63) * 65 + c4;
            tp[0] = v[i][0]; tp[1] = v[i][1]; tp[2] = v[i][2]; tp[3] = v[i][3];
        }
        if (t + tstride < total) CW_LOAD(t + tstride);
        __syncthreads();
        const int n = tid >> 3, k8 = (tid & 7) * 8;
        const int ncol = ntile * 64 + n;
        int drow = ncol;
        if (mode == 1) { drow = (ncol < DFF) ? ((ncol >> 7) * 256 + (ncol & 127)) : (((ncol - DFF) >> 7) * 256 + 128 + ((ncol - DFF) & 127)); }
        if (mode == 2 && ncol < 1024) { const int d = ncol & 63, hf = d >> 5, rem = d & 31; drow = (ncol & ~63) + (rem >> 4) * 32 + ((rem & 15) >> 2) * 8 + hf * 4 + (rem & 3); }
#pragma unroll
        for (int q = 0; q < 4; ++q) {
            float f[8];
#pragma unroll
            for (int j = 0; j < 8; ++j) f[j] = tile[q * (64 * 65) + (k8 + j) * 65 + n];
            u32x4 w; w.x = cvt_pk_bf16(f[0], f[1]); w.y = cvt_pk_bf16(f[2], f[3]); w.z = cvt_pk_bf16(f[4], f[5]); w.w = cvt_pk_bf16(f[6], f[7]);
            *(u32x4*)(dst + (size_t)drow * ldk + kg * 256 + q * 64 + k8) = w;
        }
        __syncthreads();
    }
#undef CW_LOAD
}

__device__ __forceinline__ void phase_prep(const Params& p, unsigned char* shm, int wv) {
    const int lane = lane_id_v(), wid = wv, tid = wid * 64 + lane;
    unsigned char* ws = p.ws;
    float* sil = (float*)shm;
    float* red = sil + 6144;
    for (int i = tid; i < 6144; i += 512) { const float v = i < 4096 ? p.c[i] : p.c_ctx[i - 4096]; sil[i] = v / (1.0f + expf(-v)); }
    __syncthreads();
    float* mod = (float*)(ws + OFF_MOD);
    for (int unit = blockIdx.x; unit < 288; unit += gridDim.x) {
        const int col = unit * 64 + lane;
        const float* w = p.ada_w + (size_t)(wid * 256) * 18432 + col;
        float a0 = 0.f, a1 = 0.f, a2 = 0.f;
#pragma unroll 32
        for (int k = 0; k < 256; ++k) { const float wval = __builtin_nontemporal_load(w + (size_t)k * 18432); const int kk = wid * 256 + k; a0 += sil[kk] * wval; a1 += sil[2048 + kk] * wval; a2 += sil[4096 + kk] * wval; }
        red[(wid * 3 + 0) * 64 + lane] = a0; red[(wid * 3 + 1) * 64 + lane] = a1; red[(wid * 3 + 2) * 64 + lane] = a2;
        __syncthreads();
        if (tid < 192) { const int g = tid >> 6; float s = 0.f;
#pragma unroll
            for (int k = 0; k < 8; ++k) s += red[(k * 3 + g) * 64 + lane];
            mod[g * 18432 + col] = s + p.ada_b[col]; }
        __syncthreads();
    }
    const int gt = blockIdx.x * 512 + tid, gstride = gridDim.x * 512;
    float* rcos = (float*)(ws + OFF_RCOS); float* rsin = (float*)(ws + OFF_RSIN);
    for (int i = gt; i < 8192 * 32; i += gstride) { const int t = i >> 5, fi = i & 31; const float inv = exp2f(-(float)fi * (13.287712379549449f / 32.0f)); const float ang = (float)t * inv; rcos[i] = cosf(ang); rsin[i] = sinf(ang); }
    float* acos_ = (float*)(ws + OFF_ACOS); float* asin_ = (float*)(ws + OFF_ASIN);
    for (int i = gt; i < 128 * 16; i += gstride) { const int t = i >> 4, fi = i & 15; const float inv = exp2f(-(float)fi * (13.287712379549449f / 16.0f)); const float ang = (float)t * inv; acos_[i] = cosf(ang); asin_[i] = sinf(ang); }
    { u32x4* z = (u32x4*)(ws + OFF_WMIXIN + (size_t)PROJ_LD * LDH * 2); const u32x4 zero = {0u, 0u, 0u, 0u};
      for (int i = gt; i < (4096 - PROJ_LD) * LDH / 8; i += gstride) z[i] = zero; }
    convert_w(p.f1in, (bf16_t*)(ws + OFF_WF1IN), DM, 2 * DFF, 1, shm, wv, (int)blockIdx.x, (int)gridDim.x, LDH);
    convert_w(p.f1out, (bf16_t*)(ws + OFF_WF1OUT), DFF, DM, 0, shm, wv, (int)blockIdx.x, (int)gridDim.x);
    convert_w(p.mixin, (bf16_t*)(ws + OFF_WMIXIN), DM, PROJ_LD, 2, shm, wv, (int)blockIdx.x, (int)gridDim.x, LDH);
    convert_w(p.wuq, (bf16_t*)(ws + OFF_WUQ), 512, 1536, 0, shm, wv, (int)blockIdx.x, (int)gridDim.x);
    convert_w(p.wukv, (bf16_t*)(ws + OFF_WUKV), 256, 2048, 0, shm, wv, (int)blockIdx.x, (int)gridDim.x);
    convert_w(p.mixout, (bf16_t*)(ws + OFF_WMIXOUT), DM, DM, 0, shm, wv, (int)blockIdx.x, (int)gridDim.x, LDH);
}

__device__ __forceinline__ void phase_norm(const Params& p, int mode, const float* __restrict__ gvec, int midx, int nrows, int wv) {
    const int lane = lane_id_v(), wid = wv;
    const float* mod = (const float*)(p.ws + OFF_MOD);
    const float* xc = (const float*)(p.ws + OFF_XC);
    bf16_t* h = (bf16_t*)(p.ws + OFF_H);
    f32x4 A[8], Bv[8]; int curgrp = -1;
    for (int r = blockIdx.x * 8 + wid; r < nrows; r += gridDim.x * 8) {
        const int grp = r < NLAT ? (r >> 13) : 2;
        if (grp != curgrp) {
            curgrp = grp;
#pragma unroll
            for (int i = 0; i < 8; ++i) { const int c = i * 256 + lane * 4;
                const f32x4 g4 = *(const f32x4*)(gvec + c), sc4 = *(const f32x4*)(mod + (size_t)(grp * 9 + midx + 1) * DM + c), sh4 = *(const f32x4*)(mod + (size_t)(grp * 9 + midx) * DM + c);
                A[i] = g4 * (sc4 + 1.0f); Bv[i] = sh4; }
        }
        const float* src;
        if (r < NLAT) src = (mode == 0 ? p.x : p.out) + (size_t)r * DM; else src = (mode == 0 ? p.ctx : xc) + (size_t)(r - NLAT) * DM;
        f32x4 v[8]; float ss = 0.f;
#pragma unroll
        for (int i = 0; i < 8; ++i) { v[i] = *(const f32x4*)(src + i * 256 + lane * 4); ss += v[i][0] * v[i][0] + v[i][1] * v[i][1] + v[i][2] * v[i][2] + v[i][3] * v[i][3]; }
        ss = wave_sum(ss);
        const float rstd = rsqrtf(ss * (1.0f / DM) + 1e-6f);
#pragma unroll
        for (int i = 0; i < 8; ++i) { const f32x4 y = v[i] * rstd * A[i] + Bv[i]; u32x2 w; w.x = cvt_pk_bf16(y[0], y[1]); w.y = cvt_pk_bf16(y[2], y[3]);
            *(u32x2*)(h + (size_t)r * LDH + i * 256 + lane * 4) = w; }
    }
}
__device__ __forceinline__ void phase_norm_b(const Params& p, const float* __restrict__ gvec, int midx, int wv) {
    const int lane = lane_id_v(), wid = wv;
    const float* mod = (const float*)(p.ws + OFF_MOD);
    const bf16_t* xb = (const bf16_t*)(p.ws + OFF_XB);
    bf16_t* h = (bf16_t*)(p.ws + OFF_H);
    f32x4 A[8], Bv[8]; int curgrp = -1;
    for (int r = blockIdx.x * 8 + wid; r < NLAT; r += gridDim.x * 8) {
        const int grp = r >> 13;
        if (grp != curgrp) {
            curgrp = grp;
#pragma unroll
            for (int i = 0; i < 8; ++i) { const int c = (i >> 1) * 512 + lane * 8 + (i & 1) * 4;
                const f32x4 g4 = *(const f32x4*)(gvec + c), sc4 = *(const f32x4*)(mod + (size_t)(grp * 9 + midx + 1) * DM + c), sh4 = *(const f32x4*)(mod + (size_t)(grp * 9 + midx) * DM + c);
                A[i] = g4 * (sc4 + 1.0f); Bv[i] = sh4; }
        }
        f32x4 v[8]; float ss = 0.f;
#pragma unroll
        for (int i = 0; i < 4; ++i) { const u32x4 w = *(const u32x4*)(xb + (size_t)r * DM + i * 512 + lane * 8);
            v[2 * i] = (f32x4){bflo(w.x), bfhi(w.x), bflo(w.y), bfhi(w.y)}; v[2 * i + 1] = (f32x4){bflo(w.z), bfhi(w.z), bflo(w.w), bfhi(w.w)}; }
#pragma unroll
        for (int i = 0; i < 8; ++i) ss += v[i][0] * v[i][0] + v[i][1] * v[i][1] + v[i][2] * v[i][2] + v[i][3] * v[i][3];
        ss = wave_sum(ss);
        const float rstd = rsqrtf(ss * (1.0f / DM) + 1e-6f);
#pragma unroll
        for (int i = 0; i < 4; ++i) { const f32x4 y0 = v[2 * i] * rstd * A[2 * i] + Bv[2 * i], y1 = v[2 * i + 1] * rstd * A[2 * i + 1] + Bv[2 * i + 1];
            u32x4 w; w.x = cvt_pk_bf16(y0[0], y0[1]); w.y = cvt_pk_bf16(y0[2], y0[3]); w.z = cvt_pk_bf16(y1[0], y1[1]); w.w = cvt_pk_bf16(y1[2], y1[3]);
            *(u32x4*)(h + (size_t)r * LDH + i * 512 + lane * 8) = w; }
    }
}
__device__ __forceinline__ void phase_norm_ctx(const Params& p, int wv) {
    const int lane = lane_id_v(), wid = wv;
    const float* mod = (const float*)(p.ws + OFF_MOD);
    const float* part = (const float*)(p.ws + OFF_XC);
    bf16_t* h = (bf16_t*)(p.ws + OFF_H);
    for (int rr = blockIdx.x * 8 + wid; rr < 512; rr += gridDim.x * 8) {
        f32x4 v[8]; float ss = 0.f;
#pragma unroll
        for (int i = 0; i < 8; ++i) { const int c = i * 256 + lane * 4; const size_t o = (size_t)rr * DM + c;
            f32x4 s4 = *(const f32x4*)(part + o);
#pragma unroll
            for (int k = 1; k < 11; ++k) s4 += *(const f32x4*)(part + (size_t)k * 1048576 + o);
            v[i] = *(const f32x4*)(p.ctx + o) + *(const f32x4*)(mod + (size_t)(2 * 9 + 2) * DM + c) * 0.5f * s4;
            ss += v[i][0] * v[i][0] + v[i][1] * v[i][1] + v[i][2] * v[i][2] + v[i][3] * v[i][3]; }
        ss = wave_sum(ss);
        const float rstd = rsqrtf(ss * (1.0f / DM) + 1e-6f);
#pragma unroll
        for (int i = 0; i < 8; ++i) { const int c = i * 256 + lane * 4;
            const f32x4 g4 = *(const f32x4*)(p.n2g + c), sc4 = *(const f32x4*)(mod + (size_t)(2 * 9 + 4) * DM + c), sh4 = *(const f32x4*)(mod + (size_t)(2 * 9 + 3) * DM + c);
            const f32x4 y = v[i] * rstd * g4 * (sc4 + 1.0f) + sh4; u32x2 w; w.x = cvt_pk_bf16(y[0], y[1]); w.y = cvt_pk_bf16(y[2], y[3]);
            *(u32x2*)(h + (size_t)(NLAT + rr) * LDH + c) = w; }
    }
}
__device__ __forceinline__ void phase_final(const Params& p, int wv) {
    const int lane = lane_id_v(), wid = wv;
    f32x4 G[8];
#pragma unroll
    for (int i = 0; i < 8; ++i) G[i] = *(const f32x4*)(p.fng + i * 256 + lane * 4);
    for (int r = blockIdx.x * 8 + wid; r < NLAT; r += gridDim.x * 8) {
        float* row = p.out + (size_t)r * DM;
        f32x4 v[8]; float ss = 0.f;
#pragma unroll
        for (int i = 0; i < 8; ++i) { v[i] = __builtin_nontemporal_load((const f32x4*)(row + i * 256 + lane * 4)); ss += v[i][0] * v[i][0] + v[i][1] * v[i][1] + v[i][2] * v[i][2] + v[i][3] * v[i][3]; }
        ss = wave_sum(ss);
        const float rstd = rsqrtf(ss * (1.0f / DM) + 1e-6f);
#pragma unroll
        for (int i = 0; i < 8; ++i) __builtin_nontemporal_store(v[i] * rstd * G[i], (f32x4*)(row + i * 256 + lane * 4));
    }
}

struct TokIn { u32x4 cq; u32x2 ckv; float k0, k1, k2, k3; };
template <bool LAT> __device__ __forceinline__ void tok_load(TokIn& t, const bf16_t* __restrict__ proj, const float* __restrict__ krp, int r, int lane) {
    const bf16_t* row = proj + (size_t)r * PROJ_LD;
    if (LAT) t.cq = *(const u32x4*)(row + C_CQ + lane * 8);
    t.ckv = *(const u32x2*)(row + C_CKV + lane * 4);
    t.k0 = krp[(size_t)r * 64 + lane]; t.k1 = krp[((size_t)MALL + r) * 64 + lane]; t.k2 = krp[((size_t)2 * MALL + r) * 64 + lane]; t.k3 = krp[((size_t)3 * MALL + r) * 64 + lane];
}
template <bool LAT> __device__ __forceinline__ void tok_store(const TokIn& t, const Params& p, int r, int lane) {
    bf16_t* cqn = (bf16_t*)(p.ws + OFF_CQN); bf16_t* ckvn = (bf16_t*)(p.ws + OFF_CKVN); bf16_t* Kd = (bf16_t*)(p.ws + OFF_K);
    const float* axc = (const float*)(p.ws + OFF_ACOS); const float* axs = (const float*)(p.ws + OFF_ASIN);
    if (LAT) {
        const u32x4 w = t.cq;
        float f[8] = {bflo(w.x), bfhi(w.x), bflo(w.y), bfhi(w.y), bflo(w.z), bfhi(w.z), bflo(w.w), bfhi(w.w)};
        float ss = 0.f;
#pragma unroll
        for (int j = 0; j < 8; ++j) ss += f[j] * f[j];
        ss = wave_sum(ss);
        const float rstd = rsqrtf(ss * (1.0f / 512.0f) + 1e-6f);
        const f32x4 g0 = *(const f32x4*)(p.qng + lane * 8), g1 = *(const f32x4*)(p.qng + lane * 8 + 4);
        u32x4 o; o.x = cvt_pk_bf16(f[0] * rstd * g0[0], f[1] * rstd * g0[1]); o.y = cvt_pk_bf16(f[2] * rstd * g0[2], f[3] * rstd * g0[3]);
        o.z = cvt_pk_bf16(f[4] * rstd * g1[0], f[5] * rstd * g1[1]); o.w = cvt_pk_bf16(f[6] * rstd * g1[2], f[7] * rstd * g1[3]);
        *(u32x4*)(cqn + (size_t)r * 512 + lane * 8) = o;
    }
    {
        const u32x2 w = t.ckv;
        float f[4] = {bflo(w.x), bfhi(w.x), bflo(w.y), bfhi(w.y)};
        float ss = f[0] * f[0] + f[1] * f[1] + f[2] * f[2] + f[3] * f[3];
        ss = wave_sum(ss);
        const float rstd = rsqrtf(ss * (1.0f / 256.0f) + 1e-6f);
        const f32x4 g0 = *(const f32x4*)(p.kvng + lane * 4);
        u32x2 o; o.x = cvt_pk_bf16(f[0] * rstd * g0[0], f[1] * rstd * g0[1]); o.y = cvt_pk_bf16(f[2] * rstd * g0[2], f[3] * rstd * g0[3]);
        *(u32x2*)(ckvn + (size_t)r * 256 + lane * 4) = o;
    }
    {
        float me = (t.k0 + t.k1) + (t.k2 + t.k3);
        const float partner = __shfl_xor(me, 16);
        int b, key;
        if (LAT) {
            const int tt = r & 8191; b = r >> 13; key = tt;
            const int part = lane >> 5, i = lane & 15; const bool is2 = (lane & 16) != 0;
            const int pos = part == 0 ? (tt >> 6) : (tt & 63);
            const float cs = axc[pos * 16 + i], sn = axs[pos * 16 + i];
            me = is2 ? (me * cs + partner * sn) : (me * cs - partner * sn);
        } else { const int rr = r - NLAT; b = rr >> 8; key = 8192 + (rr & 255); }
        const bf16_t o = f2bf(me);
#pragma unroll
        for (int hh = 0; hh < 8; ++hh) Kd[((size_t)(b * 8 + hh) * SKV + key) * 192 + 128 + lane] = o;
    }
}
__device__ __forceinline__ void phase_tok(const Params& p, int wv) {
    const int lane = lane_id_v();
    const bf16_t* proj = (const bf16_t*)(p.ws + OFF_PROJ);
    const float* krp = (const float*)p.out + 16777216;
    const int stride = (int)gridDim.x * 8;
    for (int r = blockIdx.x * 8 + wv; r < NLAT; r += 2 * stride) {
        const int r2 = r + stride;
        TokIn a, b2;
        tok_load<true>(a, proj, krp, r, lane);
        if (r2 < NLAT) tok_load<true>(b2, proj, krp, r2, lane);
        tok_store<true>(a, p, r, lane);
        if (r2 < NLAT) tok_store<true>(b2, p, r2, lane);
    }
    for (int r = NLAT + blockIdx.x * 8 + wv; r < MALL; r += stride) { TokIn a; tok_load<false>(a, proj, krp, r, lane); tok_store<false>(a, p, r, lane); }
}

__device__ __forceinline__ float log_sigmoid_f(float x) { return -log1pf(expf(-x)); }
__device__ __forceinline__ void load_rot_pair(const bf16_t* __restrict__ rowp, bool rope, const float* __restrict__ rc, const float* __restrict__ rs, int q, float (&o1)[8], float (&o2)[8]) {
    const u32x4 a = *(const u32x4*)(rowp + 8 * q), b = *(const u32x4*)(rowp + 32 + 8 * q);
    const float x1[8] = {bflo(a.x), bfhi(a.x), bflo(a.y), bfhi(a.y), bflo(a.z), bfhi(a.z), bflo(a.w), bfhi(a.w)};
    const float x2[8] = {bflo(b.x), bfhi(b.x), bflo(b.y), bfhi(b.y), bflo(b.z), bfhi(b.z), bflo(b.w), bfhi(b.w)};
    if (rope) {
        const f32x4 c0 = *(const f32x4*)(rc + 8 * q), c1 = *(const f32x4*)(rc + 8 * q + 4), s0 = *(const f32x4*)(rs + 8 * q), s1 = *(const f32x4*)(rs + 8 * q + 4);
        const float cs[8] = {c0[0], c0[1], c0[2], c0[3], c1[0], c1[1], c1[2], c1[3]}, sn[8] = {s0[0], s0[1], s0[2], s0[3], s1[0], s1[1], s1[2], s1[3]};
#pragma unroll
        for (int i = 0; i < 8; ++i) { o1[i] = x1[i] * cs[i] - x2[i] * sn[i]; o2[i] = x2[i] * cs[i] + x1[i] * sn[i]; }
    } else {
#pragma unroll
        for (int i = 0; i < 8; ++i) { o1[i] = x1[i]; o2[i] = x2[i]; }
    }
}
__device__ __forceinline__ void stage_vT(const bf16_t* __restrict__ proj, int row0, int h, bf16_t* vT, int wv) {
    const int tid = TIDX(wv);
#pragma unroll
    for (int i = 0; i < 4; ++i) {
        const int id = tid + 512 * i, j = id & 127, ch = id >> 7;
        const u32x4 w = *(const u32x4*)(proj + (size_t)(row0 + j) * PROJ_LD + C_RV + h * 128 + ch * 8);
        bf16_t* d = vT + (ch * 8) * 136 + j;
        d[0 * 136] = (bf16_t)(w.x & 0xffff); d[1 * 136] = (bf16_t)(w.x >> 16); d[2 * 136] = (bf16_t)(w.y & 0xffff); d[3 * 136] = (bf16_t)(w.y >> 16);
        d[4 * 136] = (bf16_t)(w.z & 0xffff); d[5 * 136] = (bf16_t)(w.z >> 16); d[6 * 136] = (bf16_t)(w.w & 0xffff); d[7 * 136] = (bf16_t)(w.w >> 16);
    }
}
__device__ __forceinline__ void phase_ret_kv(const Params& p, unsigned char* shm, int wv) {
    const int lane = lane_id_v(), wid = wv, tid = wid * 64 + lane, r32 = lane & 31, hi = lane >> 5;
    const bf16_t* proj = (const bf16_t*)(p.ws + OFF_PROJ);
    float* states = (float*)(p.ws + OFF_STATES);
    const float* rcos = (const float*)(p.ws + OFF_RCOS); const float* rsin = (const float*)(p.ws + OFF_RSIN);
    bf16_t* kTf = (bf16_t*)shm; bf16_t* kTb = kTf + 64 * 136; bf16_t* vT = kTb + 64 * 136;
    for (int u = blockIdx.x; u < 16 * 66; u += gridDim.x) {
        const int bh = u / 66, cidx = u % 66, b = bh >> 3, h = bh & 7;
        int row0, slot_f, slot_b, t0; bool rope;
        if (cidx < 2) { row0 = NLAT + b * 256 + cidx * 128; rope = false; t0 = 0; slot_f = cidx; slot_b = 1 - cidx; }
        else { const int c = cidx - 2; row0 = b * 8192 + c * 128; rope = true; t0 = c * 128; slot_f = 2 + c; slot_b = 2 + 63 - c; }
        const float lf2 = log_sigmoid_f(p.rdf[h]) * LOG2E, lb2 = log_sigmoid_f(p.rdb[h]) * LOG2E;
        __syncthreads();
        {
            const int j = tid >> 2, q = tid & 3;
            float o1[8], o2[8];
            load_rot_pair(proj + (size_t)(row0 + j) * PROJ_LD + C_RK + h * 64, false, rcos, rsin, q, o1, o2);
            const float zf = exp2f(lf2 * (float)(127 - j)), zb = exp2f(lb2 * (float)j);
#pragma unroll
            for (int i = 0; i < 8; ++i) {
                kTf[(8 * q + i) * 136 + j] = f2bf(o1[i] * zf); kTf[(32 + 8 * q + i) * 136 + j] = f2bf(o2[i] * zf);
                kTb[(8 * q + i) * 136 + j] = f2bf(o1[i] * zb); kTb[(32 + 8 * q + i) * 136 + j] = f2bf(o2[i] * zb);
            }
        }
        stage_vT(proj, row0, h, vT, wv);
        __syncthreads();
        const int me = wid & 3, dir = wid >> 2;
        const bf16_t* kT = dir ? kTb : kTf;
        f32x16 acc0 = {}, acc1 = {};
#pragma unroll
        for (int ks = 0; ks < 8; ++ks) {
            const int tok = 16 * ks + 8 * hi;
            const bf16x8 a = *(const bf16x8*)(vT + (32 * me + r32) * 136 + tok);
            const bf16x8 b0 = *(const bf16x8*)(kT + r32 * 136 + tok), b1 = *(const bf16x8*)(kT + (32 + r32) * 136 + tok);
            acc0 = __builtin_amdgcn_mfma_f32_32x32x16_bf16(a, b0, acc0, 0, 0, 0);
            acc1 = __builtin_amdgcn_mfma_f32_32x32x16_bf16(a, b1, acc1, 0, 0, 0);
        }
        float* dst = states + ((size_t)((bh * 2 + dir) * 66 + (dir ? slot_b : slot_f))) * 8192;
#pragma unroll
        for (int r = 0; r < 16; ++r) { const int e = 32 * me + att::crow(r, hi); dst[e * 64 + r32] = acc0[r]; dst[e * 64 + 32 + r32] = acc1[r]; }
    }
}
__device__ __forceinline__ void phase_scan(const Params& p, int wv) {
    const float* states = (const float*)(p.ws + OFF_STATES);
    unsigned* sb = (unsigned*)p.out;
    for (int idx = blockIdx.x * 512 + TIDX(wv); idx < 32 * 4096; idx += gridDim.x * 512) {
        const int bhd = idx >> 12, e2 = (idx & 4095) * 2, h = (bhd >> 1) & 7, dir = bhd & 1;
        const float lg = log_sigmoid_f(dir ? p.rdb[h] : p.rdf[h]); const float decay = expf(lg * 128.0f);
        const f32x2* base = (const f32x2*)(states + (size_t)bhd * 66 * 8192 + e2);
        unsigned* ob = sb + ((size_t)bhd * 66 * 8192 + e2) / 2;
        f32x2 S = {0.f, 0.f};
        for (int s0 = 0; s0 < 66; s0 += 6) {
            const f32x2 v0 = base[(size_t)(s0 + 0) * 4096], v1 = base[(size_t)(s0 + 1) * 4096], v2 = base[(size_t)(s0 + 2) * 4096];
            const f32x2 v3 = base[(size_t)(s0 + 3) * 4096], v4 = base[(size_t)(s0 + 4) * 4096], v5 = base[(size_t)(s0 + 5) * 4096];
            ob[(size_t)(s0 + 0) * 4096] = cvt_pk_bf16(S[0], S[1]); S = S * decay + v0;
            ob[(size_t)(s0 + 1) * 4096] = cvt_pk_bf16(S[0], S[1]); S = S * decay + v1;
            ob[(size_t)(s0 + 2) * 4096] = cvt_pk_bf16(S[0], S[1]); S = S * decay + v2;
            ob[(size_t)(s0 + 3) * 4096] = cvt_pk_bf16(S[0], S[1]); S = S * decay + v3;
            ob[(size_t)(s0 + 4) * 4096] = cvt_pk_bf16(S[0], S[1]); S = S * decay + v4;
            ob[(size_t)(s0 + 5) * 4096] = cvt_pk_bf16(S[0], S[1]); S = S * decay + v5;
        }
    }
}
__device__ __forceinline__ void ret_out_unit(const Params& p, unsigned char* shm, int u, int wv) {
    const int lane = lane_id_v(), w = wv, tid = w * 64 + lane, l15 = lane & 15, g = lane >> 4;
    const bf16_t* proj = (const bf16_t*)(p.ws + OFF_PROJ);
    const float* states = (const float*)(p.ws + OFF_STATES);
    const float* rcos = (const float*)(p.ws + OFF_RCOS); const float* rsin = (const float*)(p.ws + OFF_RSIN);
    bf16_t* mixcat = (bf16_t*)(p.ws + OFF_H);
    bf16_t* qs = (bf16_t*)shm; bf16_t* ksm = qs + 128 * 72; bf16_t* vT = ksm + 128 * 72; bf16_t* SfT = vT + 128 * 136; bf16_t* SbT = SfT + 128 * 72;
    const int bh = u >> 6, c = u & 63, b = bh >> 3, h = bh & 7;
    const int row0 = b * 8192 + c * 128, t0 = c * 128;
    const float lf2 = log_sigmoid_f(p.rdf[h]) * LOG2E, lb2 = log_sigmoid_f(p.rdb[h]) * LOG2E;
    {
        const int j = tid >> 2, q = tid & 3;
        const bf16_t* qp = proj + (size_t)(row0 + j) * PROJ_LD + C_RQ + h * 64;
        const bf16_t* kp = proj + (size_t)(row0 + j) * PROJ_LD + C_RK + h * 64;
        const u32x4 q1 = *(const u32x4*)(qp + 8 * q), q2 = *(const u32x4*)(qp + 32 + 8 * q), k1 = *(const u32x4*)(kp + 8 * q), k2 = *(const u32x4*)(kp + 32 + 8 * q);
        *(u32x4*)(qs + j * 72 + 8 * q) = q1; *(u32x4*)(qs + j * 72 + 32 + 8 * q) = q2;
        *(u32x4*)(ksm + j * 72 + 8 * q) = k1; *(u32x4*)(ksm + j * 72 + 32 + 8 * q) = k2;
    }
    stage_vT(proj, row0, h, vT, wv);
    {
        const bf16_t* sbf = (const bf16_t*)p.out;
        const bf16_t* Sf = sbf + ((size_t)((bh * 2 + 0) * 66 + 2 + c)) * 8192;
        const bf16_t* Sb = sbf + ((size_t)((bh * 2 + 1) * 66 + 2 + 63 - c)) * 8192;
#pragma unroll
        for (int i = 0; i < 2; ++i) {
            const int id = tid + 512 * i, e = id >> 3, d8 = (id & 7) * 8;
            *(u32x4*)(SfT + e * 72 + d8) = *(const u32x4*)(Sf + e * 64 + d8);
            *(u32x4*)(SbT + e * 72 + d8) = *(const u32x4*)(Sb + e * 64 + d8);
        }
    }
    __syncthreads();
    bf16x8 qf[2];
#pragma unroll
    for (int ks = 0; ks < 2; ++ks) qf[ks] = *(const bf16x8*)(qs + (16 * w + l15) * 72 + 32 * ks + 8 * g);
    f32x4 st[8];
    const int qi = 16 * w + l15;
#pragma unroll
    for (int t = 0; t < 8; ++t) {
        f32x4 a = {0.f, 0.f, 0.f, 0.f};
#pragma unroll
        for (int ks = 0; ks < 2; ++ks) { const bf16x8 kf = *(const bf16x8*)(ksm + (16 * t + l15) * 72 + 32 * ks + 8 * g); a = __builtin_amdgcn_mfma_f32_16x16x32_bf16(kf, qf[ks], a, 0, 0, 0); }
#pragma unroll
        for (int r = 0; r < 4; ++r) { const int kj = 16 * t + 4 * g + r; const int dl = qi - kj; const float f = dl >= 0 ? exp2f(lf2 * (float)dl) : exp2f(-lb2 * (float)dl); a[r] *= f; }
        st[t] = a;
    }
    f32x4 y[8];
#pragma unroll
    for (int nt = 0; nt < 8; ++nt) y[nt] = (f32x4){0.f, 0.f, 0.f, 0.f};
#pragma unroll
    for (int T = 0; T < 4; ++T) {
        u32x4 pw; pw.x = cvt_pk_bf16(st[2 * T][0], st[2 * T][1]); pw.y = cvt_pk_bf16(st[2 * T][2], st[2 * T][3]); pw.z = cvt_pk_bf16(st[2 * T + 1][0], st[2 * T + 1][1]); pw.w = cvt_pk_bf16(st[2 * T + 1][2], st[2 * T + 1][3]);
        const bf16x8 pa = *reinterpret_cast<const bf16x8*>(&pw);
#pragma unroll
        for (int nt = 0; nt < 8; ++nt) {
            const bf16_t* vp = vT + (16 * nt + l15) * 136 + 32 * T + 4 * g;
            const u32x2 lo = *(const u32x2*)vp, hi2 = *(const u32x2*)(vp + 16);
            u32x4 bw; bw.x = lo.x; bw.y = lo.y; bw.z = hi2.x; bw.w = hi2.y;
            y[nt] = __builtin_amdgcn_mfma_f32_16x16x32_bf16(pa, *reinterpret_cast<const bf16x8*>(&bw), y[nt], 0, 0, 0);
        }
    }
    float xif[4], xib[4];
#pragma unroll
    for (int r = 0; r < 4; ++r) { const int il = 16 * w + 4 * g + r; xif[r] = exp2f(lf2 * (float)(il + 1)); xib[r] = exp2f(lb2 * (float)(128 - il)); }
#pragma unroll
    for (int nt = 0; nt < 8; ++nt) {
        f32x4 tf = {0.f, 0.f, 0.f, 0.f}, tb = {0.f, 0.f, 0.f, 0.f};
#pragma unroll
        for (int ks = 0; ks < 2; ++ks) {
            const bf16x8 sf = *(const bf16x8*)(SfT + (16 * nt + l15) * 72 + 32 * ks + 8 * g), sb = *(const bf16x8*)(SbT + (16 * nt + l15) * 72 + 32 * ks + 8 * g);
            tf = __builtin_amdgcn_mfma_f32_16x16x32_bf16(qf[ks], sf, tf, 0, 0, 0);
            tb = __builtin_amdgcn_mfma_f32_16x16x32_bf16(qf[ks], sb, tb, 0, 0, 0);
        }
#pragma unroll
        for (int r = 0; r < 4; ++r) y[nt][r] += xif[r] * tf[r] + xib[r] * tb[r];
    }
    f32x4 yn[8];
#pragma unroll
    for (int r = 0; r < 4; ++r) {
        float s = 0.f;
#pragma unroll
        for (int nt = 0; nt < 8; ++nt) s += y[nt][r];
        s += __shfl_xor(s, 1); s += __shfl_xor(s, 2); s += __shfl_xor(s, 4); s += __shfl_xor(s, 8);
        const float mu = s * (1.0f / 128.0f);
        float q2 = 0.f;
#pragma unroll
        for (int nt = 0; nt < 8; ++nt) { const float d = y[nt][r] - mu; q2 += d * d; }
        q2 += __shfl_xor(q2, 1); q2 += __shfl_xor(q2, 2); q2 += __shfl_xor(q2, 4); q2 += __shfl_xor(q2, 8);
        const float rstd = rsqrtf(q2 * (1.0f / 128.0f) + 1e-5f);
#pragma unroll
        for (int nt = 0; nt < 8; ++nt) yn[nt][r] = (y[nt][r] - mu) * rstd;
    }
    __syncthreads();
    float* yt = (float*)shm;
#pragma unroll
    for (int r = 0; r < 4; ++r)
#pragma unroll
        for (int nt = 0; nt < 8; ++nt) yt[(16 * w + 4 * g + r) * 132 + 16 * nt + l15] = yn[nt][r];
    __syncthreads();
#pragma unroll
    for (int i = 0; i < 4; ++i) {
        const int id = tid + 512 * i, tok = id >> 4, c8 = (id & 15) * 8;
        const size_t row = (size_t)(row0 + tok);
        const u32x4 gw = *(const u32x4*)(proj + row * PROJ_LD + C_RG + h * 128 + c8);
        const f32x4 a = *(const f32x4*)(yt + tok * 132 + c8), b = *(const f32x4*)(yt + tok * 132 + c8 + 4);
        u32x4 o;
        o.x = cvt_pk_bf16(a[0] * silu_f(bflo(gw.x)), a[1] * silu_f(bfhi(gw.x))); o.y = cvt_pk_bf16(a[2] * silu_f(bflo(gw.y)), a[3] * silu_f(bfhi(gw.y)));
        o.z = cvt_pk_bf16(b[0] * silu_f(bflo(gw.z)), b[1] * silu_f(bfhi(gw.z))); o.w = cvt_pk_bf16(b[2] * silu_f(bflo(gw.w)), b[3] * silu_f(bfhi(gw.w)));
        *(u32x4*)(mixcat + row * LDH + h * 128 + c8) = o;
    }
}

#define XB_TMO      128
#define XB_XCNT(j)  (256  + 64 * (j))
#define XB_XSUB(j)  (1280 + 64 * (j))
#define XB_XGEN(j)  (2304 + 64 * (j))
#define XB_TOP      3328
#define XB_TOPGEN   3392
#define XCD_BAR_WORDS 3456
#define XB_SPIN_CAP (1u << 22)
__device__ __forceinline__ unsigned xb_ld(unsigned* p)              { return __hip_atomic_load(p, __ATOMIC_RELAXED, __HIP_MEMORY_SCOPE_AGENT); }
__device__ __forceinline__ unsigned xb_add(unsigned* p, unsigned v) { return __hip_atomic_fetch_add(p, v, __ATOMIC_RELAXED, __HIP_MEMORY_SCOPE_AGENT); }
__device__ __forceinline__ unsigned xb_xcc_id() { return (unsigned)__builtin_amdgcn_s_getreg((3 << 11) | 20) & 0xFu; }
#define XB_SPIN(cond, bar) do { unsigned _sp = 0; while (cond) { __builtin_amdgcn_s_sleep(1); \
    if ((++_sp & 255u) == 0u) { if (xb_ld(&(bar)[XB_TMO])) break; if (_sp > XB_SPIN_CAP) { atomicAdd(&(bar)[XB_TMO], 1u); break; } } } } while (0)
struct XcdBarrier { unsigned* bar; unsigned x; volatile LAS unsigned* st; };
__device__ __forceinline__ XcdBarrier xcd_barrier_post(unsigned* bar, volatile LAS unsigned* st, int wv) {
    XcdBarrier b; b.bar = bar; b.x = xb_xcc_id(); b.st = st;
    if (wv == 0 && lane_id_v() == 0) (void)xb_add(&bar[XB_XCNT(b.x)], 1u);
    return b;
}
__device__ __forceinline__ void xcd_barrier_complete(unsigned* bar, unsigned x, unsigned& nloc, unsigned& nx) {
    const unsigned G = gridDim.x * gridDim.y * gridDim.z;
    unsigned sum, cnt, mine, sp = 0u;
    for (;;) {
        sum = 0u; cnt = 0u; mine = 0u;
#pragma unroll
        for (unsigned j = 0; j < 16; ++j) { const unsigned c = xb_ld(&bar[XB_XCNT(j)]); sum += c; cnt += (c > 0u) ? 1u : 0u; mine = (j == x) ? c : mine; }
        if (sum == G) break;
        __builtin_amdgcn_s_sleep(1);
        if ((++sp & 255u) == 0u) { if (xb_ld(&bar[XB_TMO])) break; if (sp > XB_SPIN_CAP) { atomicAdd(&bar[XB_TMO], 1u); break; } }
    }
    nloc = mine > 0u ? mine : 1u; nx = cnt > 0u ? cnt : 1u;
}
__device__ __forceinline__ void xcd_barrier(const XcdBarrier& b, int wv) {
    asm volatile("s_waitcnt vmcnt(0)" ::: "memory");
    __syncthreads();
    if (wv == 0 && lane_id_v() == 0) {
        unsigned* bar = b.bar;
        __builtin_amdgcn_s_waitcnt(0);
        unsigned nloc = b.st[0], nx = b.st[1];
        if (nloc == 0u) { xcd_barrier_complete(bar, b.x, nloc, nx); b.st[0] = nloc; b.st[1] = nx; }
        const unsigned old = xb_add(&bar[XB_XSUB(b.x)], 1u);
        const unsigned gen = old / nloc;
        if (old + 1u == (gen + 1u) * nloc) {
            __builtin_amdgcn_fence(__ATOMIC_RELEASE, "agent");
            asm volatile("s_waitcnt vmcnt(0)" ::: "memory");
            const unsigned og = xb_add(&bar[XB_TOP], 1u);
            const unsigned tg = og / nx;
            if (og + 1u == (tg + 1u) * nx) xb_add(&bar[XB_TOPGEN], 1u);
            else XB_SPIN(xb_ld(&bar[XB_TOPGEN]) == tg, bar);
            __builtin_amdgcn_fence(__ATOMIC_ACQUIRE, "agent");
            xb_add(&bar[XB_XGEN(b.x)], 1u);
            asm volatile("s_waitcnt vmcnt(0)" ::: "memory");
        } else {
            XB_SPIN(xb_ld(&bar[XB_XGEN(b.x)]) == gen, bar);
            __builtin_amdgcn_fence(__ATOMIC_ACQUIRE, "agent");
            asm volatile("s_waitcnt vmcnt(0)" ::: "memory");
        }
    }
    __syncthreads();
}

__global__ void __launch_bounds__(512, 2) mega(Params p) {
    extern __shared__ __attribute__((aligned(16))) unsigned char shm[];
    cg::grid_group grid = cg::this_grid();
    volatile LAS unsigned* xst = (volatile LAS unsigned*)(LAS unsigned char*)(shm + 131072);
    unsigned* bar = (unsigned*)(p.ws + OFF_BAR);
    const int wv = __builtin_amdgcn_readfirstlane((int)(threadIdx.x >> 6));
    if (wv == 0 && lane_id_v() == 0) { xst[0] = 0u; xst[1] = 0u; }
    if (blockIdx.x == 0) { for (int i = TIDX(wv); i < XCD_BAR_WORDS; i += 512) bar[i] = 0u; }
    __syncthreads();
    unsigned char* ws = p.ws;
    float* mod = (float*)(ws + OFF_MOD);
    float* xc = (float*)(ws + OFF_XC);
    bf16_t* hbuf = (bf16_t*)(ws + OFF_H);
    bf16_t* act = (bf16_t*)(ws + OFF_ACT);
#ifndef PH_MASK
#define PH_MASK 0x3fff
#endif
#define PHASE(k) if ((PH_MASK >> (k)) & 1)
#define SYNC(k) xcd_barrier(xb, wv)
    PHASE(0) { phase_prep(p, shm, wv); }
    grid.sync();
    const XcdBarrier xb = xcd_barrier_post(bar, xst, wv);
    PHASE(1) { phase_norm(p, 0, p.n1g, 0, MALL, wv); } SYNC(1);
    PHASE(2) { { EpiSwiglu E; E.O = act; run_gemm(shm, hbuf, (const bf16_t*)(ws + OFF_WF1IN), MALL, 2 * DFF, DM, E, wv, -1, LDH, LDH); }
               const int extra = (MALL / 256) * (2 * DFF / 256) - 11 * (int)gridDim.x;
               if (gridDim.x == 256 && (int)blockIdx.x >= extra) { const int t0 = (int)blockIdx.x - extra, ts = (int)gridDim.x - extra;
                   convert_w(p.f2in, (bf16_t*)(ws + OFF_WF2IN), DM, 2 * DFF, 1, shm, wv, t0, ts, LDH); convert_w(p.f2out, (bf16_t*)(ws + OFF_WF2OUT), DFF, DM, 0, shm, wv, t0, ts); }
               else if (gridDim.x != 256) { convert_w(p.f2in, (bf16_t*)(ws + OFF_WF2IN), DM, 2 * DFF, 1, shm, wv, (int)blockIdx.x, (int)gridDim.x, LDH); convert_w(p.f2out, (bf16_t*)(ws + OFF_WF2OUT), DFF, DM, 0, shm, wv, (int)blockIdx.x, (int)gridDim.x); } } SYNC(2);
    PHASE(3) { { EpiResidB<true, false> E; E.basef = p.x; E.baseb = nullptr; E.outf = nullptr; E.outb = (bf16_t*)(ws + OFF_XB); E.mod = mod; E.gidx = 2; E.coef = 0.5f;
                 run_gemm(shm, act, (const bf16_t*)(ws + OFF_WF1OUT), NLAT, DM, DFF, E, wv); }
               { EpiPartial E; E.part = xc;
                 run_gemm_splitk<EpiPartial, 2>(shm, act + (size_t)NLAT * DFF, (const bf16_t*)(ws + OFF_WF1OUT), DM, DFF, 11, E, wv); } } SYNC(3);
    PHASE(4) { phase_norm_b(p, p.n2g, 3, wv); phase_norm_ctx(p, wv); } SYNC(4);
    PHASE(5) { { EpiProj E; E.O = (bf16_t*)(ws + OFF_PROJ); E.rcos = (const float*)(ws + OFF_RCOS); E.rsin = (const float*)(ws + OFF_RSIN);
                 run_gemm(shm, hbuf, (const bf16_t*)(ws + OFF_WMIXIN), MALL, 3840, DM, E, wv, -1, LDH, LDH); }
               { EpiKrPart E; E.part = p.out + 16777216;
                 run_gemm_splitk<EpiKrPart, 66>(shm, hbuf, (const bf16_t*)(ws + OFF_WMIXIN) + (size_t)3840 * LDH, 256, DM, 4, E, wv, LDH, (int)((blockIdx.x + 34) % gridDim.x)); } } SYNC(5);
    PHASE(6) { phase_tok(p, wv); phase_ret_kv(p, shm, wv); } SYNC(6);
    PHASE(7) { phase_scan(p, wv);
               { EpiQ E; E.Q = (bf16_t*)(ws + OFF_Q); E.axc = (const float*)(ws + OFF_ACOS); E.axs = (const float*)(ws + OFF_ASIN);
                 run_gemm(shm, (const bf16_t*)(ws + OFF_CQN), (const bf16_t*)(ws + OFF_WUQ), NLAT, 1536, 512, E, wv); }
               { EpiKV E; E.Kd = (bf16_t*)(ws + OFF_K); E.Vd = (bf16_t*)(ws + OFF_V); E.pm0 = 0;
                 run_gemm(shm, (const bf16_t*)(ws + OFF_CKVN), (const bf16_t*)(ws + OFF_WUKV), NLAT, 2048, 256, E, wv);
                 E.pm0 = 64;
                 run_gemm(shm, (const bf16_t*)(ws + OFF_CKVN) + (size_t)NLAT * 256, (const bf16_t*)(ws + OFF_WUKV), 512, 2048, 256, E, wv, (int)((blockIdx.x + gridDim.x / 2) % gridDim.x)); } } SYNC(7);
    PHASE(8) {
#ifndef NO_ATT
        for (int u = blockIdx.x; u < 512; u += gridDim.x) {
            const int b = u >> 8, rem = u & 255, h = rem & 7, qb = rem >> 3;
            const bf16_t* Qb = (const bf16_t*)(ws + OFF_Q) + (size_t)(b * 8192 + qb * 256) * 1536 + h * 192;
            const bf16_t* Kh = (const bf16_t*)(ws + OFF_K) + (size_t)(b * 8 + h) * SKV * 192;
            const bf16_t* Vh = (const bf16_t*)(ws + OFF_V) + (size_t)(b * 8 + h) * SKV * 128;
            bf16_t* Ob = hbuf + (size_t)(b * 8192 + qb * 256) * LDH + 1024 + h * 128;
            __syncthreads();
            att::attn_body(Qb, Kh, Vh, Ob, SKV, (char*)shm, wv);
        }
#endif
#ifndef NO_RET3
        for (int u = blockIdx.x; u < 1024; u += gridDim.x) { __syncthreads(); ret_out_unit(p, shm, u, wv); }
#endif
    } SYNC(8);
    PHASE(9) { EpiResidB<false, false> E; E.basef = nullptr; E.baseb = (const bf16_t*)(ws + OFF_XB); E.outf = nullptr; E.outb = (bf16_t*)(ws + OFF_XB); E.mod = mod; E.gidx = 5; E.coef = 1.0f;
               run_gemm(shm, hbuf, (const bf16_t*)(ws + OFF_WMIXOUT), NLAT, DM, DM, E, wv, -1, LDH, LDH); } SYNC(9);
    PHASE(10) { phase_norm_b(p, p.n3g, 6, wv); } SYNC(10);
    PHASE(11) { EpiSwiglu E; E.O = act; run_gemm(shm, hbuf, (const bf16_t*)(ws + OFF_WF2IN), NLAT, 2 * DFF, DM, E, wv, -1, LDH, LDH); } SYNC(11);
    PHASE(12) { EpiResidB<false, true> E; E.basef = nullptr; E.baseb = (const bf16_t*)(ws + OFF_XB); E.outf = p.out; E.outb = nullptr; E.mod = mod; E.gidx = 8; E.coef = 0.5f;
                run_gemm(shm, act, (const bf16_t*)(ws + OFF_WF2OUT), NLAT, DM, DFF, E, wv); } SYNC(12);
    PHASE(13) { phase_final(p, wv); }
#undef PHASE
#undef SYNC
}

extern "C" void kernel_launch(void* const* d_in, const int* in_sizes, int n_in, void* d_out, int out_size, void* d_ws, size_t ws_size, hipStream_t stream) {
    static int grid_blocks = 0;
    if (!grid_blocks) {
        if (n_in != 22 || ws_size < WS_END || out_size != NLAT * DM) { fprintf(stderr, "kernel_launch: unexpected shapes n_in %d ws %zu (need %zu) out %d\n", n_in, ws_size, (size_t)WS_END, out_size); return; }
        if (hipFuncSetAttribute((const void*)mega, hipFuncAttributeMaxDynamicSharedMemorySize, LDS_BYTES) != hipSuccess) { fprintf(stderr, "kernel_launch: hipFuncSetAttribute failed\n"); return; }
        int dev = 0, cus = 0, per_cu = 0;
        hipGetDevice(&dev);
        hipDeviceGetAttribute(&cus, hipDeviceAttributeMultiprocessorCount, dev);
        hipOccupancyMaxActiveBlocksPerMultiprocessor(&per_cu, mega, 512, LDS_BYTES);
        if (per_cu < 1) { fprintf(stderr, "kernel_launch: occupancy 0\n"); return; }
        grid_blocks = cus;
    }
    Params p{};
    p.x = (const float*)d_in[0]; p.c = (const float*)d_in[1]; p.ctx = (const float*)d_in[2]; p.c_ctx = (const float*)d_in[3]; p.ada_w = (const float*)d_in[4]; p.ada_b = (const float*)d_in[5];
    p.n1g = (const float*)d_in[6]; p.f1in = (const float*)d_in[7]; p.f1out = (const float*)d_in[8]; p.n2g = (const float*)d_in[9]; p.mixin = (const float*)d_in[10];
    p.rdf = (const float*)d_in[11]; p.rdb = (const float*)d_in[12]; p.qng = (const float*)d_in[13]; p.wuq = (const float*)d_in[14]; p.kvng = (const float*)d_in[15]; p.wukv = (const float*)d_in[16];
    p.mixout = (const float*)d_in[17]; p.n3g = (const float*)d_in[18]; p.f2in = (const float*)d_in[19]; p.f2out = (const float*)d_in[20]; p.fng = (const float*)d_in[21];
    p.out = (float*)d_out; p.ws = (unsigned char*)d_ws;
    void* args[] = {&p};
    hipError_t e = hipLaunchCooperativeKernel((void*)mega, dim3(grid_blocks), dim3(512), args, LDS_BYTES, stream);
    if (e != hipSuccess) fprintf(stderr, "cooperative launch failed: %s (grid %d)\n", hipGetErrorString(e), grid_blocks);
}
```

```cpp
#include <hip/hip_runtime.h>
#include <hip/hip_cooperative_groups.h>
#include <cstdio>
#include <cstdint>
namespace cg = cooperative_groups;

typedef unsigned short bf16_t;
typedef short bf16x8 __attribute__((ext_vector_type(8)));
typedef short s16x4 __attribute__((ext_vector_type(4)));
typedef float f32x4 __attribute__((ext_vector_type(4)));
typedef float f32x2 __attribute__((ext_vector_type(2)));
typedef float f32x16 __attribute__((ext_vector_type(16)));
typedef unsigned u32x4 __attribute__((ext_vector_type(4)));
typedef unsigned u32x2 __attribute__((ext_vector_type(2)));
#define LAS __attribute__((address_space(3)))

constexpr int NLAT = 16384, MALL = 16896, DM = 2048, DFF = 5632, PROJ_LD = 3904, SKV = 8448;
constexpr int C_RQ = 0, C_RK = 512, C_RV = 1024, C_RG = 2048, C_CQ = 3072, C_CKV = 3584, C_KR = 3840;
constexpr int LDH = 2112;
constexpr int LDS_BYTES = 131072 + 16;
constexpr float LOG2E = 1.4426950408889634f;

constexpr size_t OFF_MOD = 0;
constexpr size_t OFF_RCOS = OFF_MOD + 221184;
constexpr size_t OFF_RSIN = OFF_RCOS + 1048576;
constexpr size_t OFF_ACOS = OFF_RSIN + 1048576;
constexpr size_t OFF_ASIN = OFF_ACOS + 8192;
constexpr size_t OFF_WF1IN = OFF_ASIN + 8192;
constexpr size_t OFF_WF1OUT = OFF_WF1IN + (size_t)11264 * LDH * 2;
constexpr size_t OFF_STATES = OFF_WF1IN;
constexpr size_t OFF_WF2IN = OFF_WF1OUT + 23068672;
constexpr size_t OFF_WF2OUT = OFF_WF2IN + (size_t)11264 * LDH * 2;
constexpr size_t OFF_WMIXIN = OFF_WF2OUT + 23068672;
constexpr size_t OFF_WUQ = OFF_WMIXIN + (size_t)4096 * LDH * 2;
constexpr size_t OFF_WUKV = OFF_WUQ + 1572864;
constexpr size_t OFF_WMIXOUT = OFF_WUKV + 1048576;
constexpr size_t OFF_H = OFF_WMIXOUT + (size_t)2048 * LDH * 2;
constexpr size_t OFF_BIG = OFF_H + (size_t)16896 * LDH * 2;
constexpr size_t OFF_XC = OFF_BIG + 209715200;
constexpr size_t OFF_ACT = OFF_BIG;
constexpr size_t OFF_PROJ = OFF_BIG;
constexpr size_t OFF_CQN = OFF_PROJ + 131923968;
constexpr size_t OFF_CKVN = OFF_CQN + 16777216;
constexpr size_t OFF_Q = OFF_CKVN + 8650752;
constexpr size_t OFF_K = OFF_Q + 50331648;
constexpr size_t OFF_V = OFF_K + 51904512;
constexpr size_t OFF_BAR = OFF_V + 34603008;
constexpr size_t OFF_XB = OFF_BAR + 16384;
constexpr size_t WS_END = OFF_XB + 67108864;

struct Params {
    const float *x, *c, *ctx, *c_ctx, *ada_w, *ada_b, *n1g, *f1in, *f1out, *n2g, *mixin, *rdf, *rdb, *qng, *wuq, *kvng, *wukv, *mixout, *n3g, *f2in, *f2out, *fng;
    float* out;
    unsigned char* ws;
};

__device__ __forceinline__ unsigned cvt_pk_bf16(float lo, float hi) { unsigned r; asm volatile("v_cvt_pk_bf16_f32 %0, %1, %2" : "=v"(r) : "v"(lo), "v"(hi)); return r; }
__device__ __forceinline__ float bflo(unsigned w) { return __uint_as_float(w << 16); }
__device__ __forceinline__ float bfhi(unsigned w) { return __uint_as_float(w & 0xffff0000u); }
__device__ __forceinline__ float bf2f(bf16_t b) { return __uint_as_float(((unsigned)b) << 16); }
__device__ __forceinline__ bf16_t f2bf(float f) { return (bf16_t)(cvt_pk_bf16(f, 0.f) & 0xffffu); }
__device__ __forceinline__ float silu_f(float g) { return g * __builtin_amdgcn_rcpf(1.0f + __expf(-g)); }
__device__ __forceinline__ int lane_id_v() { int l; asm volatile("v_mbcnt_lo_u32_b32 %0, -1, 0\n\tv_mbcnt_hi_u32_b32 %0, -1, %0" : "=v"(l)); return l; }
#define TIDX(wv) ((wv) * 64 + lane_id_v())
__device__ __forceinline__ float wave_sum(float v) {
#pragma unroll
    for (int o = 32; o >= 1; o >>= 1) v += __shfl_xor(v, o);
    return v;
}

namespace pg8 {
constexpr int BM = 256, BK = 64, HALF = 128, HTB = HALF * BK * 2, STAGE_BYTES = 8 * HTB, NXCD = 8, WGM = 8;
__host__ __device__ __forceinline__ int lds_byte(int r, int c) { const int st = (r >> 4) * 2 + (c >> 5), rr = r & 15, cc = c & 31, ob = rr * 64 + cc * 2; return st * 1024 + (ob ^ (((ob >> 9) & 1) << 5)); }
__host__ __device__ __forceinline__ void stage_rc(int b, int& R, int& C) { const int st = b / 1024, sb = b % 1024, swz = sb ^ (((sb >> 9) & 1) << 5); R = (st >> 1) * 16 + swz / 64; C = (st & 1) * 32 + (swz % 64) / 2; }
__host__ __device__ __forceinline__ int perm32(int rho) { const int n = rho >> 4, i = rho & 15; return 8 * (i >> 2) + 4 * n + (i & 3); }
struct Unit { int pm, pn; };
struct Gemm { const bf16_t* A; const bf16_t* Bt; int M, N, K, lda, ldb; };
struct StaticOrder {
    int nM, nN, nwg, G, c;
    __device__ void init(int M, int N, int G_, int c_) { nM = M / BM; nN = N / BM; nwg = nM * nN; G = G_; c = c_; }
    __device__ bool next(int i, Unit& u) const {
        const long L = (long)i * G + c; if (L >= nwg) return false;
        int wgid = (int)L; { const int q = nwg / NXCD, r = nwg % NXCD, xcd = wgid % NXCD, off = wgid / NXCD; wgid = (xcd < r ? xcd * (q + 1) : r * (q + 1) + (xcd - r) * q) + off; }
        const int nig = WGM * nN, gid = wgid / nig, fm = gid * WGM, gsz = (nM - fm) < WGM ? (nM - fm) : WGM;
        u.pm = fm + ((wgid % nig) % gsz); u.pn = (wgid % nig) / gsz; return true;
    }
    __device__ __forceinline__ size_t a_off(const Unit& u, size_t tA) const { return (size_t)u.pm * tA; }
    __device__ __forceinline__ size_t b_off(const Unit& u, size_t tB) const { return (size_t)u.pn * tB; }
};
template <int NP> struct SplitKOrder : StaticOrder {
    size_t ksb;
    __device__ __forceinline__ size_t a_off(const Unit& u, size_t tA) const { return (size_t)(u.pm % NP) * tA + (size_t)(u.pm / NP) * ksb; }
    __device__ __forceinline__ size_t b_off(const Unit& u, size_t tB) const { return (size_t)u.pn * tB + (size_t)(u.pm / NP) * ksb; }
};
template <class Epi, class Sched>
__device__ __forceinline__ void gemm_phase(LAS unsigned char* lds, const Gemm g, const Sched& S, const Epi& E, int wv) {
    const int lane = lane_id_v(), wid = wv, tid = wid * 64 + lane, wr = wid >> 2, wc = wid & 3, fr = lane & 15, fq = lane >> 4;
    const int K = g.K, nt = K / BK;
    unsigned voffA[2], voffB[2];
#pragma unroll
    for (int i = 0; i < 2; ++i) { int R, C; stage_rc(tid * 16 + i * 8192, R, C); const int Rb = Epi::PERM ? ((R & ~31) + perm32(R & 31)) : R;
        voffA[i] = (unsigned)(R * g.lda + C) * 2u; voffB[i] = (unsigned)(Rb * g.ldb + C) * 2u; }
    const size_t kstep = (size_t)(BK * 2);
    const size_t hA = (size_t)HALF * g.lda * 2, hB = (size_t)HALF * g.ldb * 2;
    const size_t tA = 2 * hA, tB = 2 * hB;
    const unsigned ldsw = (unsigned)wid * 1024u;
    const int aoff = lds_byte(wr * 64 + fr, fq * 8), boff = lds_byte(wc * 32 + fr, fq * 8);
#define PG8_SA(b, h) (((b) * 2 + (h)) * HTB)
#define PG8_SB(b, h) ((4 + (b) * 2 + (h)) * HTB)
#define PG8_STAGE(bufoff, gbase, voff) do { _Pragma("unroll") for (int _i = 0; _i < 2; ++_i) \
        __builtin_amdgcn_global_load_lds((const unsigned*)((const char*)(gbase) + (voff)[_i]), (LAS unsigned*)(lds + (bufoff) + ldsw + _i * 8192), 16, 0, 0); } while (0)
#define PG8_LDA(dst, b, h) do { _Pragma("unroll") for (int m = 0; m < 4; ++m) _Pragma("unroll") for (int k = 0; k < 2; ++k) dst[m][k] = *(const LAS bf16x8*)(lds + PG8_SA(b, h) + aoff + m * 2048 + k * 1024); } while (0)
#define PG8_LDB(dst, b, h) do { _Pragma("unroll") for (int n = 0; n < 2; ++n) _Pragma("unroll") for (int k = 0; k < 2; ++k) dst[n][k] = *(const LAS bf16x8*)(lds + PG8_SB(b, h) + boff + n * 2048 + k * 1024); } while (0)
#define PG8_MMA(ai, bj, At, Bt) do { __builtin_amdgcn_s_setprio(1); _Pragma("unroll") for (int m = 0; m < 4; ++m) _Pragma("unroll") for (int n = 0; n < 2; ++n) _Pragma("unroll") for (int k = 0; k < 2; ++k) \
        acc[ai][bj][m][n] = __builtin_amdgcn_mfma_f32_16x16x32_bf16(Bt[n][k], At[m][k], acc[ai][bj][m][n], 0, 0, 0); __builtin_amdgcn_s_setprio(0); } while (0)
#define PG8_WAIT_V(n) asm volatile("s_waitcnt vmcnt(" #n ")" ::: "memory")
#define PG8_WAIT_L(n) asm volatile("s_waitcnt lgkmcnt(" #n ")" ::: "memory")
#define PG8_BAR __builtin_amdgcn_s_barrier()
#define PG8_SCHED __builtin_amdgcn_sched_barrier(0)
    Unit cur, nxt; int ui = 0;
    if (!S.next(0, cur)) return;
    f32x4 acc[2][2][4][2];
#pragma unroll
    for (int a = 0; a < 2; ++a)
#pragma unroll
        for (int b = 0; b < 2; ++b)
#pragma unroll
            for (int m = 0; m < 4; ++m)
#pragma unroll
                for (int n = 0; n < 2; ++n) acc[a][b][m][n] = (f32x4){0.f, 0.f, 0.f, 0.f};
    bf16x8 At[4][2], B0[2][2], B1[2][2];
    const char* cA = (const char*)g.A + S.a_off(cur, tA); const char* cB = (const char*)g.Bt + S.b_off(cur, tB);
    PG8_STAGE(PG8_SB(0, 0), cB, voffB); PG8_STAGE(PG8_SA(0, 0), cA, voffA); PG8_STAGE(PG8_SB(0, 1), cB + hB, voffB); PG8_STAGE(PG8_SA(0, 1), cA + hA, voffA);
    if (wr == 1) PG8_BAR;
    PG8_WAIT_V(4); PG8_BAR;
    PG8_STAGE(PG8_SB(1, 0), cB + kstep, voffB); PG8_STAGE(PG8_SA(1, 0), cA + kstep, voffA); PG8_STAGE(PG8_SB(1, 1), cB + hB + kstep, voffB);
    PG8_WAIT_V(6); PG8_BAR;
    for (;;) {
        const bool has_next = S.next(ui + 1, nxt);
        const char* nA = has_next ? (const char*)g.A + S.a_off(nxt, tA) : cA; const char* nB = has_next ? (const char*)g.Bt + S.b_off(nxt, tB) : cB;
        for (int t = 0; t < nt; t += 2) {
            const bool last = (t == nt - 2);
            const char* a1 = cA + (size_t)(t + 1) * kstep;
            const char* a2 = last ? nA : cA + (size_t)(t + 2) * kstep; const char* b2 = last ? nB : cB + (size_t)(t + 2) * kstep;
            const char* a3 = a2 + kstep; const char* b3 = b2 + kstep;
            PG8_LDB(B0, 0, 0); PG8_SCHED; PG8_LDA(At, 0, 0); PG8_STAGE(PG8_SA(1, 1), a1 + hA, voffA);
            PG8_WAIT_L(8); PG8_BAR; PG8_WAIT_L(0); PG8_MMA(0, 0, At, B0); PG8_BAR; PG8_SCHED;
            PG8_LDB(B1, 0, 1); PG8_STAGE(PG8_SB(0, 0), b2, voffB);
            PG8_BAR; PG8_WAIT_L(0); PG8_MMA(0, 1, At, B1); PG8_BAR;
            PG8_LDA(At, 0, 1); PG8_STAGE(PG8_SA(0, 0), a2, voffA);
            PG8_BAR; PG8_WAIT_L(0); PG8_MMA(1, 0, At, B0); PG8_BAR; PG8_SCHED;
            PG8_STAGE(PG8_SB(0, 1), b2 + hB, voffB);
            PG8_WAIT_V(6); PG8_BAR; PG8_MMA(1, 1, At, B1); PG8_BAR;
            PG8_LDB(B0, 1, 0); PG8_SCHED; PG8_LDA(At, 1, 0); PG8_STAGE(PG8_SA(0, 1), a2 + hA, voffA);
            PG8_WAIT_L(8); PG8_BAR; PG8_WAIT_L(0); PG8_MMA(0, 0, At, B0); PG8_BAR; PG8_SCHED;
            PG8_LDB(B1, 1, 1); PG8_STAGE(PG8_SB(1, 0), b3, voffB);
            PG8_BAR; PG8_WAIT_L(0); PG8_MMA(0, 1, At, B1); PG8_BAR;
            PG8_LDA(At, 1, 1); PG8_STAGE(PG8_SA(1, 0), a3, voffA);
            PG8_BAR; PG8_WAIT_L(0); PG8_MMA(1, 0, At, B0); PG8_BAR; PG8_SCHED;
            PG8_STAGE(PG8_SB(1, 1), b3 + hB, voffB);
            PG8_WAIT_V(6); PG8_BAR; PG8_MMA(1, 1, At, B1); PG8_BAR;
        }
        E(acc, cur, wr, wc, fr, fq);
        if (!has_next) break;
#pragma unroll
        for (int a = 0; a < 2; ++a)
#pragma unroll
            for (int b = 0; b < 2; ++b)
#pragma unroll
                for (int m = 0; m < 4; ++m)
#pragma unroll
                    for (int n = 0; n < 2; ++n) acc[a][b][m][n] = (f32x4){0.f, 0.f, 0.f, 0.f};
        cur = nxt; cA = nA; cB = nB; ++ui;
    }
    PG8_WAIT_V(0);
    if (wr == 0) PG8_BAR;
    PG8_BAR;
#undef PG8_SA
#undef PG8_SB
#undef PG8_STAGE
#undef PG8_LDA
#undef PG8_LDB
#undef PG8_MMA
#undef PG8_WAIT_V
#undef PG8_WAIT_L
#undef PG8_BAR
#undef PG8_SCHED
}
}

typedef f32x4 AccT[2][2][4][2];
struct EpiSwiglu {
    static constexpr bool PERM = true;
    bf16_t* O;
    __device__ __forceinline__ void operator()(const AccT& acc, const pg8::Unit& u, int wr, int wc, int fr, int fq) const {
        const int row0 = u.pm * 256 + wr * 64 + fr, col0 = u.pn * 128 + wc * 32 + 8 * fq;
#pragma unroll
        for (int ai = 0; ai < 2; ++ai)
#pragma unroll
            for (int m = 0; m < 4; ++m) {
                bf16_t* rowp = O + (size_t)(row0 + ai * 128 + m * 16) * DFF + col0;
                const f32x4 g0 = acc[ai][0][m][0], g1 = acc[ai][0][m][1], u0 = acc[ai][1][m][0], u1 = acc[ai][1][m][1];
                u32x4 w;
                w.x = cvt_pk_bf16(silu_f(g0[0]) * u0[0], silu_f(g0[1]) * u0[1]); w.y = cvt_pk_bf16(silu_f(g0[2]) * u0[2], silu_f(g0[3]) * u0[3]);
                w.z = cvt_pk_bf16(silu_f(g1[0]) * u1[0], silu_f(g1[1]) * u1[1]); w.w = cvt_pk_bf16(silu_f(g1[2]) * u1[2], silu_f(g1[3]) * u1[3]);
                *(u32x4*)rowp = w;
            }
    }
};
struct EpiResid {
    static constexpr bool PERM = false;
    const float* baseLat; const float* baseCtx; float* outLat; float* outCtx; const float* mod; int gidx; float coef;
    __device__ __forceinline__ void operator()(const AccT& acc, const pg8::Unit& u, int wr, int wc, int fr, int fq) const {
        const bool lat = u.pm < 64; const int grp = lat ? (u.pm >> 5) : 2;
        const float* base = lat ? baseLat : baseCtx; float* out = lat ? outLat : outCtx;
        const int row0 = (lat ? u.pm : u.pm - 64) * 256 + wr * 64 + fr, col0 = u.pn * 256 + wc * 32 + 4 * fq;
        const float* gp = mod + (size_t)(grp * 9 + gidx) * DM + col0;
        f32x4 gv[2][2];
#pragma unroll
        for (int bj = 0; bj < 2; ++bj)
#pragma unroll
            for (int n = 0; n < 2; ++n) gv[bj][n] = *(const f32x4*)(gp + bj * 128 + n * 16) * coef;
#pragma unroll
        for (int ai = 0; ai < 2; ++ai)
#pragma unroll
            for (int m = 0; m < 4; ++m) {
                const size_t off = (size_t)(row0 + ai * 128 + m * 16) * DM + col0;
#pragma unroll
                for (int bj = 0; bj < 2; ++bj)
#pragma unroll
                    for (int n = 0; n < 2; ++n) {
                        const f32x4 b = *(const f32x4*)(base + off + bj * 128 + n * 16);
                        *(f32x4*)(out + off + bj * 128 + n * 16) = b + gv[bj][n] * acc[ai][bj][m][n];
                    }
            }
    }
};
template <bool BASE_F32, bool OUT_F32> struct EpiResidB {
    static constexpr bool PERM = true;
    const float* basef; const bf16_t* baseb; float* outf; bf16_t* outb; const float* mod; int gidx; float coef;
    __device__ __forceinline__ void operator()(const AccT& acc, const pg8::Unit& u, int wr, int wc, int fr, int fq) const {
        const int grp = u.pm >> 5;
        const int row0 = u.pm * 256 + wr * 64 + fr, col0 = u.pn * 256 + wc * 32 + 8 * fq;
        const float* gp = mod + (size_t)(grp * 9 + gidx) * DM + col0;
        f32x4 gv[2][2];
#pragma unroll
        for (int bj = 0; bj < 2; ++bj)
#pragma unroll
            for (int n = 0; n < 2; ++n) gv[bj][n] = *(const f32x4*)(gp + bj * 128 + n * 4) * coef;
#pragma unroll
        for (int ai = 0; ai < 2; ++ai)
#pragma unroll
            for (int m = 0; m < 4; ++m) {
                const size_t off = (size_t)(row0 + ai * 128 + m * 16) * DM + col0;
#pragma unroll
                for (int bj = 0; bj < 2; ++bj) {
                    f32x4 b0, b1;
                    if (BASE_F32) { b0 = *(const f32x4*)(basef + off + bj * 128); b1 = *(const f32x4*)(basef + off + bj * 128 + 4); }
                    else { const u32x4 w = *(const u32x4*)(baseb + off + bj * 128); b0 = (f32x4){bflo(w.x), bfhi(w.x), bflo(w.y), bfhi(w.y)}; b1 = (f32x4){bflo(w.z), bfhi(w.z), bflo(w.w), bfhi(w.w)}; }
                    const f32x4 x0 = b0 + gv[bj][0] * acc[ai][bj][m][0], x1 = b1 + gv[bj][1] * acc[ai][bj][m][1];
                    if (OUT_F32) { *(f32x4*)(outf + off + bj * 128) = x0; *(f32x4*)(outf + off + bj * 128 + 4) = x1; }
                    else { u32x4 w; w.x = cvt_pk_bf16(x0[0], x0[1]); w.y = cvt_pk_bf16(x0[2], x0[3]); w.z = cvt_pk_bf16(x1[0], x1[1]); w.w = cvt_pk_bf16(x1[2], x1[3]); *(u32x4*)(outb + off + bj * 128) = w; }
                }
            }
    }
};
struct EpiKrPart {
    static constexpr bool PERM = false;
    float* part;
    __device__ __forceinline__ void operator()(const AccT& acc, const pg8::Unit& u, int wr, int wc, int fr, int fq) const {
        if (wc >= 2) return;
        const int ks = u.pm / 66, panel = u.pm % 66;
        const int row0 = panel * 256 + wr * 64 + fr, col0 = wc * 32 + 4 * fq;
#pragma unroll
        for (int ai = 0; ai < 2; ++ai)
#pragma unroll
            for (int m = 0; m < 4; ++m) {
                float* rowp = part + ((size_t)ks * MALL + row0 + ai * 128 + m * 16) * 64 + col0;
                *(f32x4*)(rowp) = acc[ai][0][m][0]; *(f32x4*)(rowp + 16) = acc[ai][0][m][1];
            }
    }
};
struct EpiPartial {
    static constexpr bool PERM = false;
    float* part;
    __device__ __forceinline__ void operator()(const AccT& acc, const pg8::Unit& u, int wr, int wc, int fr, int fq) const {
        const int row0 = u.pm * 256 + wr * 64 + fr, col0 = u.pn * 256 + wc * 32 + 4 * fq;
#pragma unroll
        for (int ai = 0; ai < 2; ++ai)
#pragma unroll
            for (int m = 0; m < 4; ++m) {
                float* rowp = part + (size_t)(row0 + ai * 128 + m * 16) * DM + col0;
#pragma unroll
                for (int bj = 0; bj < 2; ++bj)
#pragma unroll
                    for (int n = 0; n < 2; ++n) *(f32x4*)(rowp + bj * 128 + n * 16) = acc[ai][bj][m][n];
            }
    }
};
struct EpiProj {
    static constexpr bool PERM = true;
    bf16_t* O; const float* rcos; const float* rsin;
    __device__ __forceinline__ void operator()(const AccT& acc, const pg8::Unit& u, int wr, int wc, int fr, int fq) const {
        const int row0 = u.pm * 256 + wr * 64 + fr, col0 = u.pn * 256 + wc * 32 + 8 * fq;
        if (u.pn < 4) {
            const float sc = (u.pn >= 2) ? 0.125f : 1.0f;
            const bool lat = u.pm < 64;
            const int f = (wc & 1) * 16 + 4 * fq;
#pragma unroll
            for (int ai = 0; ai < 2; ++ai)
#pragma unroll
                for (int m = 0; m < 4; ++m) {
                    const int r = row0 + ai * 128 + m * 16;
                    f32x4 cs = {1.f, 1.f, 1.f, 1.f}, sn = {0.f, 0.f, 0.f, 0.f};
                    if (lat) { const int t = r & 8191; cs = *(const f32x4*)(rcos + (size_t)t * 32 + f); sn = *(const f32x4*)(rsin + (size_t)t * 32 + f); }
                    bf16_t* rowp = O + (size_t)r * PROJ_LD;
#pragma unroll
                    for (int bj = 0; bj < 2; ++bj) {
                        const int head0 = ((u.pn * 256 + bj * 128 + wc * 32) >> 6) << 6;
                        const f32x4 x1 = acc[ai][bj][m][0], x2 = acc[ai][bj][m][1];
                        const f32x4 o1 = (x1 * cs - x2 * sn) * sc, o2 = (x2 * cs + x1 * sn) * sc;
                        u32x2 a, b; a.x = cvt_pk_bf16(o1[0], o1[1]); a.y = cvt_pk_bf16(o1[2], o1[3]); b.x = cvt_pk_bf16(o2[0], o2[1]); b.y = cvt_pk_bf16(o2[2], o2[3]);
                        *(u32x2*)(rowp + head0 + f) = a; *(u32x2*)(rowp + head0 + 32 + f) = b;
                    }
                }
            return;
        }
#pragma unroll
        for (int ai = 0; ai < 2; ++ai)
#pragma unroll
            for (int m = 0; m < 4; ++m) {
                bf16_t* rowp = O + (size_t)(row0 + ai * 128 + m * 16) * PROJ_LD;
#pragma unroll
                for (int bj = 0; bj < 2; ++bj) {
                    const int c = col0 + bj * 128;
                    if (c < PROJ_LD) {
                        const f32x4 v0 = acc[ai][bj][m][0], v1 = acc[ai][bj][m][1];
                        u32x4 w; w.x = cvt_pk_bf16(v0[0], v0[1]); w.y = cvt_pk_bf16(v0[2], v0[3]); w.z = cvt_pk_bf16(v1[0], v1[1]); w.w = cvt_pk_bf16(v1[2], v1[3]);
                        *(u32x4*)(rowp + c) = w;
                    }
                }
            }
    }
};
struct EpiQ {
    static constexpr bool PERM = false;
    bf16_t* Q; const float* axc; const float* axs;
    __device__ __forceinline__ void operator()(const AccT& acc, const pg8::Unit& u, int wr, int wc, int fr, int fq) const {
        const int row0 = u.pm * 256 + wr * 64 + fr;
#pragma unroll
        for (int bj = 0; bj < 2; ++bj) {
            const int grp32 = 8 * u.pn + 4 * bj + wc; const int w6 = grp32 % 6; const bool rope = w6 >= 4; const int part = w6 - 4;
            const int col = grp32 * 32 + 4 * fq;
#pragma unroll
            for (int ai = 0; ai < 2; ++ai)
#pragma unroll
                for (int m = 0; m < 4; ++m) {
                    const int r = row0 + ai * 128 + m * 16; const int t = r & 8191; const int pos = (part == 0) ? (t >> 6) : (t & 63);
                    f32x4 x1 = acc[ai][bj][m][0], x2 = acc[ai][bj][m][1];
                    if (rope) {
                        const f32x4 cs = *(const f32x4*)(axc + pos * 16 + 4 * fq), sn = *(const f32x4*)(axs + pos * 16 + 4 * fq);
                        const f32x4 o1 = x1 * cs - x2 * sn, o2 = x2 * cs + x1 * sn; x1 = o1; x2 = o2;
                    }
                    bf16_t* rowp = Q + (size_t)r * 1536 + col;
                    u32x2 a, b; a.x = cvt_pk_bf16(x1[0], x1[1]); a.y = cvt_pk_bf16(x1[2], x1[3]); b.x = cvt_pk_bf16(x2[0], x2[1]); b.y = cvt_pk_bf16(x2[2], x2[3]);
                    *(u32x2*)rowp = a; *(u32x2*)(rowp + 16) = b;
                }
        }
    }
};
struct EpiKV {
    static constexpr bool PERM = true;
    bf16_t* Kd; bf16_t* Vd; int pm0;
    __device__ __forceinline__ void operator()(const AccT& acc, const pg8::Unit& u, int wr, int wc, int fr, int fq) const {
        const int pmg = u.pm + pm0; const bool lat = pmg < 64; const int b = lat ? (pmg >> 5) : (pmg - 64); const int key0 = lat ? (pmg & 31) * 256 : 8192;
        const int e0 = wc * 32 + 8 * fq; const size_t bh = (size_t)(b * 8 + u.pn) * SKV;
#pragma unroll
        for (int ai = 0; ai < 2; ++ai)
#pragma unroll
            for (int m = 0; m < 4; ++m) {
                const size_t key = bh + key0 + ai * 128 + wr * 64 + m * 16 + fr;
                { const f32x4 v0 = acc[ai][0][m][0], v1 = acc[ai][0][m][1]; u32x4 w; w.x = cvt_pk_bf16(v0[0], v0[1]); w.y = cvt_pk_bf16(v0[2], v0[3]); w.z = cvt_pk_bf16(v1[0], v1[1]); w.w = cvt_pk_bf16(v1[2], v1[3]);
                  *(u32x4*)(Kd + key * 192 + e0) = w; }
                { const f32x4 v0 = acc[ai][1][m][0], v1 = acc[ai][1][m][1]; u32x4 w; w.x = cvt_pk_bf16(v0[0], v0[1]); w.y = cvt_pk_bf16(v0[2], v0[3]); w.z = cvt_pk_bf16(v1[0], v1[1]); w.w = cvt_pk_bf16(v1[2], v1[3]);
                  *(u32x4*)(Vd + key * 128 + e0) = w; }
            }
    }
};

template <class Epi>
__device__ __forceinline__ void run_gemm(unsigned char* shm, const bf16_t* A, const bf16_t* Bt, int M, int N, int K, const Epi& E, int wv, int cblk = -1, int lda = 0, int ldb = 0) {
    __syncthreads();
    pg8::Gemm g; g.A = A; g.Bt = Bt; g.M = M; g.N = N; g.K = K; g.lda = lda ? lda : K; g.ldb = ldb ? ldb : K;
    pg8::StaticOrder S; S.init(M, N, (int)gridDim.x, cblk < 0 ? (int)blockIdx.x : cblk);
    pg8::gemm_phase<Epi, pg8::StaticOrder>((LAS unsigned char*)shm, g, S, E, wv);
    __syncthreads();
}
template <class Epi, int NP>
__device__ __forceinline__ void run_gemm_splitk(unsigned char* shm, const bf16_t* A, const bf16_t* Bt, int N, int K, int KS, const Epi& E, int wv, int ld = 0, int cblk = -1) {
    __syncthreads();
    pg8::Gemm g; g.A = A; g.Bt = Bt; g.M = NP * 256 * KS; g.N = N; g.K = K / KS; g.lda = ld ? ld : K; g.ldb = ld ? ld : K;
    pg8::SplitKOrder<NP> S; S.init(g.M, N, (int)gridDim.x, cblk < 0 ? (int)blockIdx.x : cblk); S.ksb = (size_t)(K / KS) * 2;
    pg8::gemm_phase<Epi, pg8::SplitKOrder<NP>>((LAS unsigned char*)shm, g, S, E, wv);
    __syncthreads();
}

namespace att {
constexpr int QBLK = 32, KVBLK = 64, LDQ = 1536, LDO = LDH;
constexpr float SCALE = 0.07216878364870323f;
constexpr float THR = 8.f;
constexpr int SHM_V = 64 * 128 * 2, SHM_K = 64 * 192 * 2;
#ifndef ATT_NQR
#define ATT_NQR 12
#endif
constexpr int NQR = ATT_NQR;
#define KSWZ(row, colB) ((row) * 384 + ((colB) ^ ((((row) >> 1) & 7) << 4)))
#define SBAR() __builtin_amdgcn_sched_barrier(0)
__device__ __forceinline__ int crow(int r, int hi) { return (r & 3) + 8 * (r >> 2) + 4 * hi; }
__device__ __forceinline__ void partialSM(f32x16& p0, f32x16& p1, float& m_reg, float& mn, float& alpha) {
    constexpr float C = SCALE * 1.4426950408889634f;
    float pmax = p0[0];
#pragma unroll
    for (int r = 1; r < 16; ++r) pmax = fmaxf(pmax, p0[r]);
#pragma unroll
    for (int r = 0; r < 16; ++r) pmax = fmaxf(pmax, p1[r]);
    { auto rr = __builtin_amdgcn_permlane32_swap(__float_as_uint(pmax), __float_as_uint(pmax), false, false);
      pmax = fmaxf(__uint_as_float(rr[0]), __uint_as_float(rr[1])); }
    if (__builtin_expect(__all(pmax - m_reg <= THR / SCALE), 1)) { mn = m_reg; alpha = 1.f; }
    else { mn = fmaxf(m_reg, pmax); alpha = __builtin_amdgcn_exp2f((m_reg - mn) * C); m_reg = mn; }
    const float mnC = -mn * C;
#pragma unroll
    for (int r = 0; r < 16; ++r) p0[r] = fmaf(p0[r], C, mnC);
#pragma unroll
    for (int r = 0; r < 16; ++r) p1[r] = fmaf(p1[r], C, mnC);
#pragma unroll
    for (int r = 0; r < 16; ++r) p0[r] = __builtin_amdgcn_exp2f(p0[r]);
}
__device__ __forceinline__ void finishSM(f32x16& p0, f32x16& p1, float alpha, float& l_reg, bf16x8& pa0, bf16x8& pa1, bf16x8& pa2, bf16x8& pa3) {
#pragma unroll
    for (int r = 0; r < 16; ++r) p1[r] = __builtin_amdgcn_exp2f(p1[r]);
    float ps = 0;
#pragma unroll
    for (int r = 0; r < 16; ++r) ps += p0[r];
#pragma unroll
    for (int r = 0; r < 16; ++r) ps += p1[r];
    { auto rr = __builtin_amdgcn_permlane32_swap(__float_as_uint(ps), __float_as_uint(ps), false, false);
      ps = __uint_as_float(rr[0]) + __uint_as_float(rr[1]); }
    l_reg = l_reg * alpha + ps;
#define PK4(P, BASE, OUT) do { unsigned a0 = cvt_pk_bf16(P[BASE + 0], P[BASE + 1]), a1 = cvt_pk_bf16(P[BASE + 2], P[BASE + 3]);   \
    unsigned b0 = cvt_pk_bf16(P[BASE + 4], P[BASE + 5]), b1 = cvt_pk_bf16(P[BASE + 6], P[BASE + 7]);                              \
    auto r0 = __builtin_amdgcn_permlane32_swap(a0, b0, false, false); auto r1 = __builtin_amdgcn_permlane32_swap(a1, b1, false, false); \
    u32x4 w = {r0[0], r1[0], r0[1], r1[1]}; OUT = *reinterpret_cast<bf16x8*>(&w); } while (0)
    PK4(p0, 0, pa0); PK4(p0, 8, pa1); PK4(p1, 0, pa2); PK4(p1, 8, pa3);
#undef PK4
}
__device__ __forceinline__ void qkt(f32x16& p0, f32x16& p1, const char* Ks, const bf16x8* qr, const char* qro, int r32, int hi) {
    p0 = f32x16{}; p1 = f32x16{};
#pragma unroll
    for (int d0 = 0; d0 < 12; ++d0) { const int cb = (d0 * 16 + hi * 8) * 2;
        const bf16x8 b0 = *reinterpret_cast<const bf16x8*>(Ks + KSWZ(r32, cb));
        const bf16x8 b1 = *reinterpret_cast<const bf16x8*>(Ks + KSWZ(32 + r32, cb));
        const bf16x8 qv = d0 < NQR ? qr[d0 < NQR ? d0 : 0] : *reinterpret_cast<const bf16x8*>(qro + (d0 - NQR) * 1024);
        p0 = __builtin_amdgcn_mfma_f32_32x32x16_bf16(b0, qv, p0, 0, 0, 0);
        p1 = __builtin_amdgcn_mfma_f32_32x32x16_bf16(b1, qv, p1, 0, 0, 0); }
}
__device__ __forceinline__ int v_st(int k, int c) { const int kk = (k & ~0xC) | ((k & 4) << 1) | ((k & 8) >> 1); return ((kk >> 3) * 4 + (c >> 5)) * 512 + ((kk & 7) * 32 + (c & 31)) * 2; }
__device__ __forceinline__ int v_rd_base(int lane) { return ((lane & 3) << 3) | (((lane >> 2) & 3) << 6) | (((lane >> 4) & 1) << 5) | (((lane >> 5) & 1) << 8); }
constexpr int v_rd_off(int d0, int ks, int half) { return d0 * 512 + ks * 4096 + half * 2048; }
template <int OFF> __device__ __forceinline__ s16x4 tr_read(int vb) {
    s16x4 r; asm volatile("ds_read_b64_tr_b16 %0, %1 offset:%2" : "=&v"(r) : "v"(vb), "i"(OFF) : "memory"); return r;
}
template <int D0> __device__ __forceinline__ void pv_one(f32x16& od, int vb, bf16x8 pa0, bf16x8 pa1, bf16x8 pa2, bf16x8 pa3) {
    const s16x4 l0 = tr_read<v_rd_off(D0, 0, 0)>(vb), h0 = tr_read<v_rd_off(D0, 0, 1)>(vb), l1 = tr_read<v_rd_off(D0, 1, 0)>(vb), h1 = tr_read<v_rd_off(D0, 1, 1)>(vb);
    const s16x4 l2 = tr_read<v_rd_off(D0, 2, 0)>(vb), h2 = tr_read<v_rd_off(D0, 2, 1)>(vb), l3 = tr_read<v_rd_off(D0, 3, 0)>(vb), h3 = tr_read<v_rd_off(D0, 3, 1)>(vb);
    asm volatile("s_waitcnt lgkmcnt(0)" ::: "memory"); SBAR();
#define PK(L, H) (bf16x8){L[0], L[1], L[2], L[3], H[0], H[1], H[2], H[3]}
    od = __builtin_amdgcn_mfma_f32_32x32x16_bf16(pa0, PK(l0, h0), od, 0, 0, 0);
    od = __builtin_amdgcn_mfma_f32_32x32x16_bf16(pa1, PK(l1, h1), od, 0, 0, 0);
    od = __builtin_amdgcn_mfma_f32_32x32x16_bf16(pa2, PK(l2, h2), od, 0, 0, 0);
    od = __builtin_amdgcn_mfma_f32_32x32x16_bf16(pa3, PK(l3, h3), od, 0, 0, 0);
#undef PK
}
__device__ __forceinline__ void pv_d0(f32x16* o, int vb, bf16x8 pa0, bf16x8 pa1, bf16x8 pa2, bf16x8 pa3) {
    pv_one<0>(o[0], vb, pa0, pa1, pa2, pa3); pv_one<1>(o[1], vb, pa0, pa1, pa2, pa3); pv_one<2>(o[2], vb, pa0, pa1, pa2, pa3); pv_one<3>(o[3], vb, pa0, pa1, pa2, pa3);
}
__device__ __forceinline__ void attn_body(const bf16_t* __restrict__ Qb, const bf16_t* __restrict__ Kh, const bf16_t* __restrict__ Vh, bf16_t* __restrict__ Ob, int seq, char* lds, int wv) {
    const int lane = lane_id_v(), wid = wv, r32 = lane & 31, hi = lane >> 5;
    char* V_lds = lds; char* K_lds = lds + 2 * SHM_V;
    float* ws = (float*)(lds + 2 * SHM_V + 2 * SHM_K) + wid * 64; float* li_l = ws; float* al_l = ws + 32;
    float m_reg = -1e30f, l_reg = 0; f32x16 o[4] = {}; bf16x8 qr[NQR];
    const bf16_t* Qw = Qb + (long)(wid * QBLK + r32) * LDQ + hi * 8;
    char* qro = lds + 2 * SHM_V + 2 * SHM_K + 2048 + wid * ((12 - NQR) * 1024) + lane * 16;
#pragma unroll
    for (int d0 = 0; d0 < NQR; ++d0) qr[d0] = *reinterpret_cast<const bf16x8*>(Qw + d0 * 16);
#pragma unroll
    for (int d0 = NQR; d0 < 12; ++d0) *reinterpret_cast<bf16x8*>(qro + (d0 - NQR) * 1024) = *reinterpret_cast<const bf16x8*>(Qw + d0 * 16);
    const int wu = wv;
    unsigned ksrc[3], vsrc[2];
#pragma unroll
    for (int i = 0; i < 3; ++i) { const int pp = (i * 8 + wid) * 64 + lane, row = pp / 24, cpos = pp - row * 24, c = (cpos & ~7) | ((cpos ^ (row >> 1)) & 7); ksrc[i] = (unsigned)(row * 192 + c * 8) * 2u; }
#pragma unroll
    for (int i = 0; i < 2; ++i) { const int pp = (i * 8 + wid) * 64 + lane, kk = (pp >> 7) * 8 + ((pp & 31) >> 2), k = (kk & ~0xC) | ((kk & 4) << 1) | ((kk & 8) >> 1), c = ((pp >> 5) & 3) * 32 + (pp & 3) * 8;
        vsrc[i] = (unsigned)(k * 128 + c) * 2u; }
    LAS unsigned char* ldsl = (LAS unsigned char*)lds;
    const int vb0 = (int)(uintptr_t)V_lds + v_rd_base(lane);
#define DMA_K(k0, b) do { const char* kb_ = (const char*)Kh + (size_t)(k0) * 384; _Pragma("unroll") for (int i_ = 0; i_ < 3; ++i_) \
    __builtin_amdgcn_global_load_lds((const unsigned*)(kb_ + ksrc[i_]), (LAS unsigned*)(ldsl + 2 * SHM_V + (b) * SHM_K + (i_ * 8 + wu) * 1024), 16, 0, 0); } while (0)
#define DMA_V(k0, b) do { const char* vb_ = (const char*)Vh + (size_t)(k0) * 256; _Pragma("unroll") for (int i_ = 0; i_ < 2; ++i_) \
    __builtin_amdgcn_global_load_lds((const unsigned*)(vb_ + vsrc[i_]), (LAS unsigned*)(ldsl + (b) * SHM_V + (i_ * 8 + wu) * 1024), 16, 0, 0); } while (0)
#define ABAR1() do { asm volatile("s_waitcnt lgkmcnt(0)" ::: "memory"); __builtin_amdgcn_s_barrier(); asm volatile("" ::: "memory"); } while (0)
#define ABAR2(n) do { asm volatile("s_waitcnt vmcnt(" #n ") lgkmcnt(0)" ::: "memory"); __builtin_amdgcn_s_barrier(); asm volatile("" ::: "memory"); } while (0)
#define RESC(a) do { if (__any((a) < 1.f)) { if (hi == 0) al_l[r32] = (a); asm volatile("s_waitcnt lgkmcnt(0)" ::: "memory"); \
    _Pragma("unroll") for (int d = 0; d < 4; ++d) _Pragma("unroll") for (int r = 0; r < 16; ++r) o[d][r] *= al_l[crow(r, hi)]; } } while (0)
    f32x16 pA0, pA1, pB0, pB1; float mnA, mnB, alA, alB; bf16x8 pa0, pa1, pa2, pa3; const int NT = seq / KVBLK;
    DMA_K(0, 0); DMA_V(0, 0); ABAR2(0);
    DMA_K(KVBLK, 1);
    qkt(pA0, pA1, K_lds, qr, qro, r32, hi); partialSM(pA0, pA1, m_reg, mnA, alA);
    DMA_V(KVBLK, 1);
    ABAR2(2);
    for (int j = 1; j + 1 < NT; j += 2) {
        DMA_K((j + 1) * KVBLK, 0);
        SBAR(); qkt(pB0, pB1, K_lds + SHM_K, qr, qro, r32, hi);
        finishSM(pA0, pA1, alA, l_reg, pa0, pa1, pa2, pa3); SBAR();
        pv_d0(o, vb0, pa0, pa1, pa2, pa3); partialSM(pB0, pB1, m_reg, mnB, alB);
        ABAR1(); DMA_V((j + 1) * KVBLK, 0);
        RESC(alB); ABAR2(2);
        DMA_K((j + 2) * KVBLK, 1);
        SBAR(); qkt(pA0, pA1, K_lds, qr, qro, r32, hi);
        finishSM(pB0, pB1, alB, l_reg, pa0, pa1, pa2, pa3); SBAR();
        pv_d0(o, vb0 + SHM_V, pa0, pa1, pa2, pa3); partialSM(pA0, pA1, m_reg, mnA, alA);
        ABAR1(); DMA_V((j + 2) * KVBLK, 1);
        RESC(alA); ABAR2(2);
    }
    SBAR(); qkt(pB0, pB1, K_lds + SHM_K, qr, qro, r32, hi);
    finishSM(pA0, pA1, alA, l_reg, pa0, pa1, pa2, pa3); SBAR();
    pv_d0(o, vb0, pa0, pa1, pa2, pa3); partialSM(pB0, pB1, m_reg, mnB, alB);
    ABAR2(0); RESC(alB);
    finishSM(pB0, pB1, alB, l_reg, pa0, pa1, pa2, pa3); SBAR();
    pv_d0(o, vb0 + SHM_V, pa0, pa1, pa2, pa3);
    if (hi == 0) li_l[r32] = l_reg; asm volatile("s_waitcnt lgkmcnt(0)" ::: "memory");
    float rli[16];
#pragma unroll
    for (int r = 0; r < 16; ++r) rli[r] = __builtin_amdgcn_rcpf(li_l[crow(r, hi)]);
    bf16_t* Ow = Ob + (long)(wid * QBLK) * LDO;
#pragma unroll
    for (int r = 0; r < 16; ++r) { const int orow = crow(r, hi);
#pragma unroll
        for (int d0 = 0; d0 < 4; ++d0) Ow[(long)orow * LDO + d0 * 32 + r32] = f2bf(o[d0][r] * rli[r]); }
#undef DMA_K
#undef DMA_V
#undef ABAR1
#undef ABAR2
#undef RESC
}
}

__device__ __forceinline__ void convert_w(const float* __restrict__ src, bf16_t* __restrict__ dst, int K, int N, int mode, unsigned char* shm, int wv, int t0, int tstride, int ldk = 0) {
    if (ldk == 0) ldk = K;
    float* tile = (float*)shm;
    const int tid = TIDX(wv), nkg = K >> 8, nnt = N >> 6, total = nkg * nnt;
    f32x4 v[8];
#define CW_LOAD(T) do { const int kg_ = (T) % nkg, nt_ = (T) / nkg; _Pragma("unroll") for (int i = 0; i < 8; ++i) { const int r = (tid >> 4) + 32 * i, c4 = (tid & 15) * 4; \
        v[i] = __builtin_nontemporal_load((const f32x4*)(src + (size_t)(kg_ * 256 + r) * N + nt_ * 64 + c4)); } } while (0)
    if (t0 < total) CW_LOAD(t0);
    for (int t = t0; t < total; t += tstride) {
        const int kg = t % nkg, ntile = t / nkg;
#pragma unroll
        for (int i = 0; i < 8; ++i) {
            const int r = (tid >> 4) + 32 * i, c4 = (tid & 15) * 4;
            float* tp = tile + (r >> 6) * (64 * 65) + (r & 63) * 65 + c4;
            tp[0] = v[i][0]; tp[1] = v[i][1]; tp[2] = v[i][2]; tp[3] = v[i][3];
        }
        if (t + tstride < total) CW_LOAD(t + tstride);
        __syncthreads();
        const int n = tid >> 3, k8 = (tid & 7) * 8;
        const int ncol = ntile * 64 + n;
        int drow = ncol;
        if (mode == 1) { drow = (ncol < DFF) ? ((ncol >> 7) * 256 + (ncol & 127)) : (((ncol - DFF) >> 7) * 256 + 128 + ((ncol - DFF) & 127)); }
        if (mode == 2 && ncol < 1024) { const int d = ncol & 63, hf = d >> 5, rem = d & 31; drow = (ncol & ~63) + (rem >> 4) * 32 + ((rem & 15) >> 2) * 8 + hf * 4 + (rem & 3); }
#pragma unroll
        for (int q = 0; q < 4; ++q) {
            float f[8];
#pragma unroll
            for (int j = 0; j < 8; ++j) f[j] = tile[q * (64 * 65) + (k8 + j) * 65 + n];
            u32x4 w; w.x = cvt_pk_bf16(f[0], f[1]); w.y = cvt_pk_bf16(f[2], f[3]); w.z = cvt_pk_bf16(f[4], f[5]); w.w = cvt_pk_bf16(f[6], f[7]);
            *(u32x4*)(dst + (size_t)drow * ldk + kg * 256 + q * 64 + k8) = w;
        }
        __syncthreads();
    }
#undef CW_LOAD
}

__device__ __forceinline__ void phase_prep(const Params& p, unsigned char* shm, int wv) {
    const int lane = lane_id_v(), wid = wv, tid = wid * 64 + lane;
    unsigned char* ws = p.ws;
    float* sil = (float*)shm;
    float* red = sil + 6144;
    for (int i = tid; i < 6144; i += 512) { const float v = i < 4096 ? p.c[i] : p.c_ctx[i - 4096]; sil[i] = v / (1.0f + expf(-v)); }
    __syncthreads();
    float* mod = (float*)(ws + OFF_MOD);
    for (int unit = blockIdx.x; unit < 288; unit += gridDim.x) {
        const int col = unit * 64 + lane;
        const float* w = p.ada_w + (size_t)(wid * 256) * 18432 + col;
        float a0 = 0.f, a1 = 0.f, a2 = 0.f;
#pragma unroll 32
        for (int k = 0; k < 256; ++k) { const float wval = __builtin_nontemporal_load(w + (size_t)k * 18432); const int kk = wid * 256 + k; a0 += sil[kk] * wval; a1 += sil[2048 + kk] * wval; a2 += sil[4096 + kk] * wval; }
        red[(wid * 3 + 0) * 64 + lane] = a0; red[(wid * 3 + 1) * 64 + lane] = a1; red[(wid * 3 + 2) * 64 + lane] = a2;
        __syncthreads();
        if (tid < 192) { const int g = tid >> 6; float s = 0.f;
#pragma unroll
            for (int k = 0; k < 8; ++k) s += red[(k * 3 + g) * 64 + lane];
            mod[g * 18432 + col] = s + p.ada_b[col]; }
        __syncthreads();
    }
    const int gt = blockIdx.x * 512 + tid, gstride = gridDim.x * 512;
    float* rcos = (float*)(ws + OFF_RCOS); float* rsin = (float*)(ws + OFF_RSIN);
    for (int i = gt; i < 8192 * 32; i += gstride) { const int t = i >> 5, fi = i & 31; const float inv = exp2f(-(float)fi * (13.287712379549449f / 32.0f)); const float ang = (float)t * inv; rcos[i] = cosf(ang); rsin[i] = sinf(ang); }
    float* acos_ = (float*)(ws + OFF_ACOS); float* asin_ = (float*)(ws + OFF_ASIN);
    for (int i = gt; i < 128 * 16; i += gstride) { const int t = i >> 4, fi = i & 15; const float inv = exp2f(-(float)fi * (13.287712379549449f / 16.0f)); const float ang = (float)t * inv; acos_[i] = cosf(ang); asin_[i] = sinf(ang); }
    { u32x4* z = (u32x4*)(ws + OFF_WMIXIN + (size_t)PROJ_LD * LDH * 2); const u32x4 zero = {0u, 0u, 0u, 0u};
      for (int i = gt; i < (4096 - PROJ_LD) * LDH / 8; i += gstride) z[i] = zero; }
    convert_w(p.f1in, (bf16_t*)(ws + OFF_WF1IN), DM, 2 * DFF, 1, shm, wv, (int)blockIdx.x, (int)gridDim.x, LDH);
    convert_w(p.f1out, (bf16_t*)(ws + OFF_WF1OUT), DFF, DM, 0, shm, wv, (int)blockIdx.x, (int)gridDim.x);
    convert_w(p.mixin, (bf16_t*)(ws + OFF_WMIXIN), DM, PROJ_LD, 2, shm, wv, (int)blockIdx.x, (int)gridDim.x, LDH);
    convert_w(p.wuq, (bf16_t*)(ws + OFF_WUQ), 512, 1536, 0, shm, wv, (int)blockIdx.x, (int)gridDim.x);
    convert_w(p.wukv, (bf16_t*)(ws + OFF_WUKV), 256, 2048, 0, shm, wv, (int)blockIdx.x, (int)gridDim.x);
    convert_w(p.mixout, (bf16_t*)(ws + OFF_WMIXOUT), DM, DM, 0, shm, wv, (int)blockIdx.x, (int)gridDim.x, LDH);
}

__device__ __forceinline__ void phase_norm(const Params& p, int mode, const float* __restrict__ gvec, int midx, int nrows, int wv) {
    const int lane = lane_id_v(), wid = wv;
    const float* mod = (const float*)(p.ws + OFF_MOD);
    const float* xc = (const float*)(p.ws + OFF_XC);
    bf16_t* h = (bf16_t*)(p.ws + OFF_H);
    f32x4 A[8], Bv[8]; int curgrp = -1;
    for (int r = blockIdx.x * 8 + wid; r < nrows; r += gridDim.x * 8) {
        const int grp = r < NLAT ? (r >> 13) : 2;
        if (grp != curgrp) {
            curgrp = grp;
#pragma unroll
            for (int i = 0; i < 8; ++i) { const int c = i * 256 + lane * 4;
                const f32x4 g4 = *(const f32x4*)(gvec + c), sc4 = *(const f32x4*)(mod + (size_t)(grp * 9 + midx + 1) * DM + c), sh4 = *(const f32x4*)(mod + (size_t)(grp * 9 + midx) * DM + c);
                A[i] = g4 * (sc4 + 1.0f); Bv[i] = sh4; }
        }
        const float* src;
        if (r < NLAT) src = (mode == 0 ? p.x : p.out) + (size_t)r * DM; else src = (mode == 0 ? p.ctx : xc) + (size_t)(r - NLAT) * DM;
        f32x4 v[8]; float ss = 0.f;
#pragma unroll
        for (int i = 0; i < 8; ++i) { v[i] = __builtin_nontemporal_load((const f32x4*)(src + i * 256 + lane * 4));     ss += v[i][0] * v[i][0] + v[i][1] * v[i][1] + v[i][2] * v[i][2] + v[i][3] * v[i][3]; }
        ss = wave_sum(ss);
        const float rstd = rsqrtf(ss * (1.0f / DM) + 1e-6f);
#pragma unroll
        for (int i = 0; i < 8; ++i) { const f32x4 y = v[i] * rstd * A[i] + Bv[i]; u32x2 w; w.x = cvt_pk_bf16(y[0], y[1]); w.y = cvt_pk_bf16(y[2], y[3]);
            *(u32x2*)(h + (size_t)r * LDH + i * 256 + lane * 4) = w; }
    }
}
__device__ __forceinline__ void phase_norm_b(const Params& p, const float* __restrict__ gvec, int midx, int wv) {
    const int lane = lane_id_v(), wid = wv;
    const float* mod = (const float*)(p.ws + OFF_MOD);
    const bf16_t* xb = (const bf16_t*)(p.ws + OFF_XB);
    bf16_t* h = (bf16_t*)(p.ws + OFF_H);
    f32x4 A[8], Bv[8]; int curgrp = -1;
    for (int r = blockIdx.x * 8 + wid; r < NLAT; r += gridDim.x * 8) {
        const int grp = r >> 13;
        if (grp != curgrp) {
            curgrp = grp;
#pragma unroll
            for (int i = 0; i < 8; ++i) { const int c = (i >> 1) * 512 + lane * 8 + (i & 1) * 4;
                const f32x4 g4 = *(const f32x4*)(gvec + c), sc4 = *(const f32x4*)(mod + (size_t)(grp * 9 + midx + 1) * DM + c), sh4 = *(const f32x4*)(mod + (size_t)(grp * 9 + midx) * DM + c);
                A[i] = g4 * (sc4 + 1.0f); Bv[i] = sh4; }
        }
        f32x4 v[8]; float ss = 0.f;
#pragma unroll
        for (int i = 0; i < 4; ++i) { const u32x4 w = *(const u32x4*)(xb + (size_t)r * DM + i * 512 + lane * 8);
            v[2 * i] = (f32x4){bflo(w.x), bfhi(w.x), bflo(w.y), bfhi(w.y)}; v[2 * i + 1] = (f32x4){bflo(w.z), bfhi(w.z), bflo(w.w), bfhi(w.w)}; }
#pragma unroll
        for (int i = 0; i < 8; ++i) ss += v[i][0] * v[i][0] + v[i][1] * v[i][1] + v[i][2] * v[i][2] + v[i][3] * v[i][3];
        ss = wave_sum(ss);
        const float rstd = rsqrtf(ss * (1.0f / DM) + 1e-6f);
#pragma unroll
        for (int i = 0; i < 4; ++i) { const f32x4 y0 = v[2 * i] * rstd * A[2 * i] + Bv[2 * i], y1 = v[2 * i + 1] * rstd * A[2 * i + 1] + Bv[2 * i + 1];
            u32x4 w; w.x = cvt_pk_bf16(y0[0], y0[1]); w.y = cvt_pk_bf16(y0[2], y0[3]); w.z = cvt_pk_bf16(y1[0], y1[1]); w.w = cvt_pk_bf16(y1[2], y1[3]);
            *(u32x4*)(h + (size_t)r * LDH + i * 512 + lane * 8) = w; }
    }
}
__device__ __forceinline__ void phase_norm_ctx(const Params& p, int wv) {
    const int lane = lane_id_v(), wid = wv;
    const float* mod = (const float*)(p.ws + OFF_MOD);
    const float* part = (const float*)(p.ws + OFF_XC);
    bf16_t* h = (bf16_t*)(p.ws + OFF_H);
    for (int rr = blockIdx.x * 8 + wid; rr < 512; rr += gridDim.x * 8) {
        f32x4 v[8]; float ss = 0.f;
#pragma unroll
        for (int i = 0; i < 8; ++i) { const int c = i * 256 + lane * 4; const size_t o = (size_t)rr * DM + c;
            f32x4 s4 = *(const f32x4*)(part + o);
#pragma unroll
            for (int k = 1; k < 11; ++k) s4 += *(const f32x4*)(part + (size_t)k * 1048576 + o);
            v[i] = *(const f32x4*)(p.ctx + o) + *(const f32x4*)(mod + (size_t)(2 * 9 + 2) * DM + c) * 0.5f * s4;
            ss += v[i][0] * v[i][0] + v[i][1] * v[i][1] + v[i][2] * v[i][2] + v[i][3] * v[i][3]; }
        ss = wave_sum(ss);
        const float rstd = rsqrtf(ss * (1.0f / DM) + 1e-6f);
#pragma unroll
        for (int i = 0; i < 8; ++i) { const int c = i * 256 + lane * 4;
            const f32x4 g4 = *(const f32x4*)(p.n2g + c), sc4 = *(const f32x4*)(mod + (size_t)(2 * 9 + 4) * DM + c), sh4 = *(const f32x4*)(mod + (size_t)(2 * 9 + 3) * DM + c);
            const f32x4 y = v[i] * rstd * g4 * (sc4 + 1.0f) + sh4; u32x2 w; w.x = cvt_pk_bf16(y[0], y[1]); w.y = cvt_pk_bf16(y[2], y[3]);
            *(u32x2*)(h + (size_t)(NLAT + rr) * LDH + c) = w; }
    }
}
__device__ __forceinline__ void phase_final(const Params& p, int wv) {
    const int lane = lane_id_v(), wid = wv;
    f32x4 G[8];
#pragma unroll
    for (int i = 0; i < 8; ++i) G[i] = *(const f32x4*)(p.fng + i * 256 + lane * 4);
    for (int r = blockIdx.x * 8 + wid; r < NLAT; r += gridDim.x * 8) {
        float* row = p.out + (size_t)r * DM;
        f32x4 v[8]; float ss = 0.f;
#pragma unroll
        for (int i = 0; i < 8; ++i) { v[i] = *(const f32x4*)(row + i * 256 + lane * 4); ss += v[i][0] * v[i][0] + v[i][1] * v[i][1] + v[i][2] * v[i][2] + v[i][3] * v[i][3]; }
        ss = wave_sum(ss);
        const float rstd = rsqrtf(ss * (1.0f / DM) + 1e-6f);
#pragma unroll
        for (int i = 0; i < 8; ++i) __builtin_nontemporal_store(v[i] * rstd * G[i], (f32x4*)(row + i * 256 + lane * 4));
    }
}

struct TokIn { u32x4 cq; u32x2 ckv; float k0, k1, k2, k3; };
template <bool LAT> __device__ __forceinline__ void tok_load(TokIn& t, const bf16_t* __restrict__ proj, const float* __restrict__ krp, int r, int lane) {
    const bf16_t* row = proj + (size_t)r * PROJ_LD;
    if (LAT) t.cq = *(const u32x4*)(row + C_CQ + lane * 8);
    t.ckv = *(const u32x2*)(row + C_CKV + lane * 4);
    t.k0 = krp[(size_t)r * 64 + lane]; t.k1 = krp[((size_t)MALL + r) * 64 + lane]; t.k2 = krp[((size_t)2 * MALL + r) * 64 + lane]; t.k3 = krp[((size_t)3 * MALL + r) * 64 + lane];
}
template <bool LAT> __device__ __forceinline__ void tok_store(const TokIn& t, const Params& p, int r, int lane) {
    bf16_t* cqn = (bf16_t*)(p.ws + OFF_CQN); bf16_t* ckvn = (bf16_t*)(p.ws + OFF_CKVN); bf16_t* Kd = (bf16_t*)(p.ws + OFF_K);
    const float* axc = (const float*)(p.ws + OFF_ACOS); const float* axs = (const float*)(p.ws + OFF_ASIN);
    if (LAT) {
        const u32x4 w = t.cq;
        float f[8] = {bflo(w.x), bfhi(w.x), bflo(w.y), bfhi(w.y), bflo(w.z), bfhi(w.z), bflo(w.w), bfhi(w.w)};
        float ss = 0.f;
#pragma unroll
        for (int j = 0; j < 8; ++j) ss += f[j] * f[j];
        ss = wave_sum(ss);
        const float rstd = rsqrtf(ss * (1.0f / 512.0f) + 1e-6f);
        const f32x4 g0 = *(const f32x4*)(p.qng + lane * 8), g1 = *(const f32x4*)(p.qng + lane * 8 + 4);
        u32x4 o; o.x = cvt_pk_bf16(f[0] * rstd * g0[0], f[1] * rstd * g0[1]); o.y = cvt_pk_bf16(f[2] * rstd * g0[2], f[3] * rstd * g0[3]);
        o.z = cvt_pk_bf16(f[4] * rstd * g1[0], f[5] * rstd * g1[1]); o.w = cvt_pk_bf16(f[6] * rstd * g1[2], f[7] * rstd * g1[3]);
        *(u32x4*)(cqn + (size_t)r * 512 + lane * 8) = o;
    }
    {
        const u32x2 w = t.ckv;
        float f[4] = {bflo(w.x), bfhi(w.x), bflo(w.y), bfhi(w.y)};
        float ss = f[0] * f[0] + f[1] * f[1] + f[2] * f[2] + f[3] * f[3];
        ss = wave_sum(ss);
        const float rstd = rsqrtf(ss * (1.0f / 256.0f) + 1e-6f);
        const f32x4 g0 = *(const f32x4*)(p.kvng + lane * 4);
        u32x2 o; o.x = cvt_pk_bf16(f[0] * rstd * g0[0], f[1] * rstd * g0[1]); o.y = cvt_pk_bf16(f[2] * rstd * g0[2], f[3] * rstd * g0[3]);
        *(u32x2*)(ckvn + (size_t)r * 256 + lane * 4) = o;
    }
    {
        float me = (t.k0 + t.k1) + (t.k2 + t.k3);
        const float partner = __shfl_xor(me, 16);
        int b, key;
        if (LAT) {
            const int tt = r & 8191; b = r >> 13; key = tt;
            const int part = lane >> 5, i = lane & 15; const bool is2 = (lane & 16) != 0;
            const int pos = part == 0 ? (tt >> 6) : (tt & 63);
            const float cs = axc[pos * 16 + i], sn = axs[pos * 16 + i];
            me = is2 ? (me * cs + partner * sn) : (me * cs - partner * sn);
        } else { const int rr = r - NLAT; b = rr >> 8; key = 8192 + (rr & 255); }
        const bf16_t o = f2bf(me);
#pragma unroll
        for (int hh = 0; hh < 8; ++hh) Kd[((size_t)(b * 8 + hh) * SKV + key) * 192 + 128 + lane] = o;
    }
}
__device__ __forceinline__ void phase_tok(const Params& p, int wv) {
    const int lane = lane_id_v();
    const bf16_t* proj = (const bf16_t*)(p.ws + OFF_PROJ);
    const float* krp = (const float*)p.out + 16777216;
    const int stride = (int)gridDim.x * 8;
    for (int r = blockIdx.x * 8 + wv; r < NLAT; r += 2 * stride) {
        const int r2 = r + stride;
        TokIn a, b2;
        tok_load<true>(a, proj, krp, r, lane);
        if (r2 < NLAT) tok_load<true>(b2, proj, krp, r2, lane);
        tok_store<true>(a, p, r, lane);
        if (r2 < NLAT) tok_store<true>(b2, p, r2, lane);
    }
    for (int r = NLAT + blockIdx.x * 8 + wv; r < MALL; r += stride) { TokIn a; tok_load<false>(a, proj, krp, r, lane); tok_store<false>(a, p, r, lane); }
}

__device__ __forceinline__ float log_sigmoid_f(float x) { return -log1pf(expf(-x)); }
__device__ __forceinline__ void load_rot_pair(const bf16_t* __restrict__ rowp, bool rope, const float* __restrict__ rc, const float* __restrict__ rs, int q, float (&o1)[8], float (&o2)[8]) {
    const u32x4 a = *(const u32x4*)(rowp + 8 * q), b = *(const u32x4*)(rowp + 32 + 8 * q);
    const float x1[8] = {bflo(a.x), bfhi(a.x), bflo(a.y), bfhi(a.y), bflo(a.z), bfhi(a.z), bflo(a.w), bfhi(a.w)};
    const float x2[8] = {bflo(b.x), bfhi(b.x), bflo(b.y), bfhi(b.y), bflo(b.z), bfhi(b.z), bflo(b.w), bfhi(b.w)};
    if (rope) {
        const f32x4 c0 = *(const f32x4*)(rc + 8 * q), c1 = *(const f32x4*)(rc + 8 * q + 4), s0 = *(const f32x4*)(rs + 8 * q), s1 = *(const f32x4*)(rs + 8 * q + 4);
        const float cs[8] = {c0[0], c0[1], c0[2], c0[3], c1[0], c1[1], c1[2], c1[3]}, sn[8] = {s0[0], s0[1], s0[2], s0[3], s1[0], s1[1], s1[2], s1[3]};
#pragma unroll
        for (int i = 0; i < 8; ++i) { o1[i] = x1[i] * cs[i] - x2[i] * sn[i]; o2[i] = x2[i] * cs[i] + x1[i] * sn[i]; }
    } else {
#pragma unroll
        for (int i = 0; i < 8; ++i) { o1[i] = x1[i]; o2[i] = x2[i]; }
    }
}
__device__ __forceinline__ void stage_vT(const bf16_t* __restrict__ proj, int row0, int h, bf16_t* vT, int wv) {
    const int tid = TIDX(wv);
#pragma unroll
    for (int i = 0; i < 4; ++i) {
        const int id = tid + 512 * i, j = id & 127, ch = id >> 7;
        const u32x4 w = *(const u32x4*)(proj + (size_t)(row0 + j) * PROJ_LD + C_RV + h * 128 + ch * 8);
        bf16_t* d = vT + (ch * 8) * 136 + j;
        d[0 * 136] = (bf16_t)(w.x & 0xffff); d[1 * 136] = (bf16_t)(w.x >> 16); d[2 * 136] = (bf16_t)(w.y & 0xffff); d[3 * 136] = (bf16_t)(w.y >> 16);
        d[4 * 136] = (bf16_t)(w.z & 0xffff); d[5 * 136] = (bf16_t)(w.z >> 16); d[6 * 136] = (bf16_t)(w.w & 0xffff); d[7 * 136] = (bf16_t)(w.w >> 16);
    }
}
__device__ __forceinline__ void phase_ret_kv(const Params& p, unsigned char* shm, int wv) {
    const int lane = lane_id_v(), wid = wv, tid = wid * 64 + lane, r32 = lane & 31, hi = lane >> 5;
    const bf16_t* proj = (const bf16_t*)(p.ws + OFF_PROJ);
    float* states = (float*)(p.ws + OFF_STATES);
    const float* rcos = (const float*)(p.ws + OFF_RCOS); const float* rsin = (const float*)(p.ws + OFF_RSIN);
    bf16_t* kTf = (bf16_t*)shm; bf16_t* kTb = kTf + 64 * 136; bf16_t* vT = kTb + 64 * 136;
    for (int u = blockIdx.x; u < 16 * 66; u += gridDim.x) {
        const int bh = u / 66, cidx = u % 66, b = bh >> 3, h = bh & 7;
        int row0, slot_f, slot_b, t0; bool rope;
        if (cidx < 2) { row0 = NLAT + b * 256 + cidx * 128; rope = false; t0 = 0; slot_f = cidx; slot_b = 1 - cidx; }
        else { const int c = cidx - 2; row0 = b * 8192 + c * 128; rope = true; t0 = c * 128; slot_f = 2 + c; slot_b = 2 + 63 - c; }
        const float lf2 = log_sigmoid_f(p.rdf[h]) * LOG2E, lb2 = log_sigmoid_f(p.rdb[h]) * LOG2E;
        __syncthreads();
        {
            const int j = tid >> 2, q = tid & 3;
            float o1[8], o2[8];
            load_rot_pair(proj + (size_t)(row0 + j) * PROJ_LD + C_RK + h * 64, false, rcos, rsin, q, o1, o2);
            const float zf = exp2f(lf2 * (float)(127 - j)), zb = exp2f(lb2 * (float)j);
#pragma unroll
            for (int i = 0; i < 8; ++i) {
                kTf[(8 * q + i) * 136 + j] = f2bf(o1[i] * zf); kTf[(32 + 8 * q + i) * 136 + j] = f2bf(o2[i] * zf);
                kTb[(8 * q + i) * 136 + j] = f2bf(o1[i] * zb); kTb[(32 + 8 * q + i) * 136 + j] = f2bf(o2[i] * zb);
            }
        }
        stage_vT(proj, row0, h, vT, wv);
        __syncthreads();
        const int me = wid & 3, dir = wid >> 2;
        const bf16_t* kT = dir ? kTb : kTf;
        f32x16 acc0 = {}, acc1 = {};
#pragma unroll
        for (int ks = 0; ks < 8; ++ks) {
            const int tok = 16 * ks + 8 * hi;
            const bf16x8 a = *(const bf16x8*)(vT + (32 * me + r32) * 136 + tok);
            const bf16x8 b0 = *(const bf16x8*)(kT + r32 * 136 + tok), b1 = *(const bf16x8*)(kT + (32 + r32) * 136 + tok);
            acc0 = __builtin_amdgcn_mfma_f32_32x32x16_bf16(a, b0, acc0, 0, 0, 0);
            acc1 = __builtin_amdgcn_mfma_f32_32x32x16_bf16(a, b1, acc1, 0, 0, 0);
        }
        float* dst = states + ((size_t)((bh * 2 + dir) * 66 + (dir ? slot_b : slot_f))) * 8192;
#pragma unroll
        for (int r = 0; r < 16; ++r) { const int e = 32 * me + att::crow(r, hi); dst[e * 64 + r32] = acc0[r]; dst[e * 64 + 32 + r32] = acc1[r]; }
    }
}
__device__ __forceinline__ void phase_scan(const Params& p, int wv) {
    const float* states = (const float*)(p.ws + OFF_STATES);
    unsigned* sb = (unsigned*)p.out;
    for (int idx = blockIdx.x * 512 + TIDX(wv); idx < 32 * 4096; idx += gridDim.x * 512) {
        const int bhd = idx >> 12, e2 = (idx & 4095) * 2, h = (bhd >> 1) & 7, dir = bhd & 1;
        const float lg = log_sigmoid_f(dir ? p.rdb[h] : p.rdf[h]); const float decay = expf(lg * 128.0f);
        const f32x2* base = (const f32x2*)(states + (size_t)bhd * 66 * 8192 + e2);
        unsigned* ob = sb + ((size_t)bhd * 66 * 8192 + e2) / 2;
        f32x2 S = {0.f, 0.f};
        for (int s0 = 0; s0 < 66; s0 += 6) {
            const f32x2 v0 = base[(size_t)(s0 + 0) * 4096], v1 = base[(size_t)(s0 + 1) * 4096], v2 = base[(size_t)(s0 + 2) * 4096];
            const f32x2 v3 = base[(size_t)(s0 + 3) * 4096], v4 = base[(size_t)(s0 + 4) * 4096], v5 = base[(size_t)(s0 + 5) * 4096];
            ob[(size_t)(s0 + 0) * 4096] = cvt_pk_bf16(S[0], S[1]); S = S * decay + v0;
            ob[(size_t)(s0 + 1) * 4096] = cvt_pk_bf16(S[0], S[1]); S = S * decay + v1;
            ob[(size_t)(s0 + 2) * 4096] = cvt_pk_bf16(S[0], S[1]); S = S * decay + v2;
            ob[(size_t)(s0 + 3) * 4096] = cvt_pk_bf16(S[0], S[1]); S = S * decay + v3;
            ob[(size_t)(s0 + 4) * 4096] = cvt_pk_bf16(S[0], S[1]); S = S * decay + v4;
            ob[(size_t)(s0 + 5) * 4096] = cvt_pk_bf16(S[0], S[1]); S = S * decay + v5;
        }
    }
}
__device__ __forceinline__ void ret_out_unit(const Params& p, unsigned char* shm, int u, int wv) {
    const int lane = lane_id_v(), w = wv, tid = w * 64 + lane, l15 = lane & 15, g = lane >> 4;
    const bf16_t* proj = (const bf16_t*)(p.ws + OFF_PROJ);
    const float* states = (const float*)(p.ws + OFF_STATES);
    const float* rcos = (const float*)(p.ws + OFF_RCOS); const float* rsin = (const float*)(p.ws + OFF_RSIN);
    bf16_t* mixcat = (bf16_t*)(p.ws + OFF_H);
    bf16_t* qs = (bf16_t*)shm; bf16_t* ksm = qs + 128 * 72; bf16_t* vT = ksm + 128 * 72; bf16_t* SfT = vT + 128 * 136; bf16_t* SbT = SfT + 128 * 72;
    const int bh = u >> 6, c = u & 63, b = bh >> 3, h = bh & 7;
    const int row0 = b * 8192 + c * 128, t0 = c * 128;
    const float lf2 = log_sigmoid_f(p.rdf[h]) * LOG2E, lb2 = log_sigmoid_f(p.rdb[h]) * LOG2E;
    {
        const int j = tid >> 2, q = tid & 3;
        const bf16_t* qp = proj + (size_t)(row0 + j) * PROJ_LD + C_RQ + h * 64;
        const bf16_t* kp = proj + (size_t)(row0 + j) * PROJ_LD + C_RK + h * 64;
        const u32x4 q1 = *(const u32x4*)(qp + 8 * q), q2 = *(const u32x4*)(qp + 32 + 8 * q), k1 = *(const u32x4*)(kp + 8 * q), k2 = *(const u32x4*)(kp + 32 + 8 * q);
        *(u32x4*)(qs + j * 72 + 8 * q) = q1; *(u32x4*)(qs + j * 72 + 32 + 8 * q) = q2;
        *(u32x4*)(ksm + j * 72 + 8 * q) = k1; *(u32x4*)(ksm + j * 72 + 32 + 8 * q) = k2;
    }
    stage_vT(proj, row0, h, vT, wv);
    {
        const bf16_t* sbf = (const bf16_t*)p.out;
        const bf16_t* Sf = sbf + ((size_t)((bh * 2 + 0) * 66 + 2 + c)) * 8192;
        const bf16_t* Sb = sbf + ((size_t)((bh * 2 + 1) * 66 + 2 + 63 - c)) * 8192;
#pragma unroll
        for (int i = 0; i < 2; ++i) {
            const int id = tid + 512 * i, e = id >> 3, d8 = (id & 7) * 8;
            *(u32x4*)(SfT + e * 72 + d8) = *(const u32x4*)(Sf + e * 64 + d8);
            *(u32x4*)(SbT + e * 72 + d8) = *(const u32x4*)(Sb + e * 64 + d8);
        }
    }
    __syncthreads();
    bf16x8 qf[2];
#pragma unroll
    for (int ks = 0; ks < 2; ++ks) qf[ks] = *(const bf16x8*)(qs + (16 * w + l15) * 72 + 32 * ks + 8 * g);
    f32x4 st[8];
    const int qi = 16 * w + l15;
#pragma unroll
    for (int t = 0; t < 8; ++t) {
        f32x4 a = {0.f, 0.f, 0.f, 0.f};
#pragma unroll
        for (int ks = 0; ks < 2; ++ks) { const bf16x8 kf = *(const bf16x8*)(ksm + (16 * t + l15) * 72 + 32 * ks + 8 * g); a = __builtin_amdgcn_mfma_f32_16x16x32_bf16(kf, qf[ks], a, 0, 0, 0); }
#pragma unroll
        for (int r = 0; r < 4; ++r) { const int kj = 16 * t + 4 * g + r; const int dl = qi - kj; const float f = dl >= 0 ? exp2f(lf2 * (float)dl) : exp2f(-lb2 * (float)dl); a[r] *= f; }
        st[t] = a;
    }
    f32x4 y[8];
#pragma unroll
    for (int nt = 0; nt < 8; ++nt) y[nt] = (f32x4){0.f, 0.f, 0.f, 0.f};
#pragma unroll
    for (int T = 0; T < 4; ++T) {
        u32x4 pw; pw.x = cvt_pk_bf16(st[2 * T][0], st[2 * T][1]); pw.y = cvt_pk_bf16(st[2 * T][2], st[2 * T][3]); pw.z = cvt_pk_bf16(st[2 * T + 1][0], st[2 * T + 1][1]); pw.w = cvt_pk_bf16(st[2 * T + 1][2], st[2 * T + 1][3]);
        const bf16x8 pa = *reinterpret_cast<const bf16x8*>(&pw);
#pragma unroll
        for (int nt = 0; nt < 8; ++nt) {
            const bf16_t* vp = vT + (16 * nt + l15) * 136 + 32 * T + 4 * g;
            const u32x2 lo = *(const u32x2*)vp, hi2 = *(const u32x2*)(vp + 16);
            u32x4 bw; bw.x = lo.x; bw.y = lo.y; bw.z = hi2.x; bw.w = hi2.y;
            y[nt] = __builtin_amdgcn_mfma_f32_16x16x32_bf16(pa, *reinterpret_cast<const bf16x8*>(&bw), y[nt], 0, 0, 0);
        }
    }
    float xif[4], xib[4];
#pragma unroll
    for (int r = 0; r < 4; ++r) { const int il = 16 * w + 4 * g + r; xif[r] = exp2f(lf2 * (float)(il + 1)); xib[r] = exp2f(lb2 * (float)(128 - il)); }
#pragma unroll
    for (int nt = 0; nt < 8; ++nt) {
        f32x4 tf = {0.f, 0.f, 0.f, 0.f}, tb = {0.f, 0.f, 0.f, 0.f};
#pragma unroll
        for (int ks = 0; ks < 2; ++ks) {
            const bf16x8 sf = *(const bf16x8*)(SfT + (16 * nt + l15) * 72 + 32 * ks + 8 * g), sb = *(const bf16x8*)(SbT + (16 * nt + l15) * 72 + 32 * ks + 8 * g);
            tf = __builtin_amdgcn_mfma_f32_16x16x32_bf16(qf[ks], sf, tf, 0, 0, 0);
            tb = __builtin_amdgcn_mfma_f32_16x16x32_bf16(qf[ks], sb, tb, 0, 0, 0);
        }
#pragma unroll
        for (int r = 0; r < 4; ++r) y[nt][r] += xif[r] * tf[r] + xib[r] * tb[r];
    }
    f32x4 yn[8];
#pragma unroll
    for (int r = 0; r < 4; ++r) {
        float s = 0.f;
#pragma unroll
        for (int nt = 0; nt < 8; ++nt) s += y[nt][r];
        s += __shfl_xor(s, 1); s += __shfl_xor(s, 2); s += __shfl_xor(s, 4); s += __shfl_xor(s, 8);
        const float mu = s * (1.0f / 128.0f);
        float q2 = 0.f;
#pragma unroll
        for (int nt = 0; nt < 8; ++nt) { const float d = y[nt][r] - mu; q2 += d * d; }
        q2 += __shfl_xor(q2, 1); q2 += __shfl_xor(q2, 2); q2 += __shfl_xor(q2, 4); q2 += __shfl_xor(q2, 8);
        const float rstd = rsqrtf(q2 * (1.0f / 128.0f) + 1e-5f);
#pragma unroll
        for (int nt = 0; nt < 8; ++nt) yn[nt][r] = (y[nt][r] - mu) * rstd;
    }
    __syncthreads();
    float* yt = (float*)shm;
#pragma unroll
    for (int r = 0; r < 4; ++r)
#pragma unroll
        for (int nt = 0; nt < 8; ++nt) yt[(16 * w + 4 * g + r) * 132 + 16 * nt + l15] = yn[nt][r];
    __syncthreads();
#pragma unroll
    for (int i = 0; i < 4; ++i) {
        const int id = tid + 512 * i, tok = id >> 4, c8 = (id & 15) * 8;
        const size_t row = (size_t)(row0 + tok);
        const u32x4 gw = *(const u32x4*)(proj + row * PROJ_LD + C_RG + h * 128 + c8);
        const f32x4 a = *(const f32x4*)(yt + tok * 132 + c8), b = *(const f32x4*)(yt + tok * 132 + c8 + 4);
        u32x4 o;
        o.x = cvt_pk_bf16(a[0] * silu_f(bflo(gw.x)), a[1] * silu_f(bfhi(gw.x))); o.y = cvt_pk_bf16(a[2] * silu_f(bflo(gw.y)), a[3] * silu_f(bfhi(gw.y)));
        o.z = cvt_pk_bf16(b[0] * silu_f(bflo(gw.z)), b[1] * silu_f(bfhi(gw.z))); o.w = cvt_pk_bf16(b[2] * silu_f(bflo(gw.w)), b[3] * silu_f(bfhi(gw.w)));
        *(u32x4*)(mixcat + row * LDH + h * 128 + c8) = o;
    }
}

#define XB_TMO      128
#define XB_XCNT(j)  (256  + 64 * (j))
#define XB_XSUB(j)  (1280 + 64 * (j))
#define XB_XGEN(j)  (2304 + 64 * (j))
#define XB_TOP      3328
#define XB_TOPGEN   3392
#define XCD_BAR_WORDS 3456
#define XB_SPIN_CAP (1u << 22)
__device__ __forceinline__ unsigned xb_ld(unsigned* p)              { return __hip_atomic_load(p, __ATOMIC_RELAXED, __HIP_MEMORY_SCOPE_AGENT); }
__device__ __forceinline__ unsigned xb_add(unsigned* p, unsigned v) { return __hip_atomic_fetch_add(p, v, __ATOMIC_RELAXED, __HIP_MEMORY_SCOPE_AGENT); }
__device__ __forceinline__ unsigned xb_xcc_id() { return (unsigned)__builtin_amdgcn_s_getreg((3 << 11) | 20) & 0xFu; }
#define XB_SPIN(cond, bar) do { unsigned _sp = 0; while (cond) { __builtin_amdgcn_s_sleep(1); \
    if ((++_sp & 255u) == 0u) { if (xb_ld(&(bar)[XB_TMO])) break; if (_sp > XB_SPIN_CAP) { atomicAdd(&(bar)[XB_TMO], 1u); break; } } } } while (0)
struct XcdBarrier { unsigned* bar; unsigned x; volatile LAS unsigned* st; };
__device__ __forceinline__ XcdBarrier xcd_barrier_post(unsigned* bar, volatile LAS unsigned* st, int wv) {
    XcdBarrier b; b.bar = bar; b.x = xb_xcc_id(); b.st = st;
    if (wv == 0 && lane_id_v() == 0) (void)xb_add(&bar[XB_XCNT(b.x)], 1u);
    return b;
}
__device__ __forceinline__ void xcd_barrier_complete(unsigned* bar, unsigned x, unsigned& nloc, unsigned& nx) {
    const unsigned G = gridDim.x * gridDim.y * gridDim.z;
    unsigned sum, cnt, mine, sp = 0u;
    for (;;) {
        sum = 0u; cnt = 0u; mine = 0u;
#pragma unroll
        for (unsigned j = 0; j < 16; ++j) { const unsigned c = xb_ld(&bar[XB_XCNT(j)]); sum += c; cnt += (c > 0u) ? 1u : 0u; mine = (j == x) ? c : mine; }
        if (sum == G) break;
        __builtin_amdgcn_s_sleep(1);
        if ((++sp & 255u) == 0u) { if (xb_ld(&bar[XB_TMO])) break; if (sp > XB_SPIN_CAP) { atomicAdd(&bar[XB_TMO], 1u); break; } }
    }
    nloc = mine > 0u ? mine : 1u; nx = cnt > 0u ? cnt : 1u;
}
__device__ __forceinline__ void xcd_barrier(const XcdBarrier& b, int wv) {
    asm volatile("s_waitcnt vmcnt(0)" ::: "memory");
    __syncthreads();
    if (wv == 0 && lane_id_v() == 0) {
        unsigned* bar = b.bar;
        __builtin_amdgcn_s_waitcnt(0);
        unsigned nloc = b.st[0], nx = b.st[1];
        if (nloc == 0u) { xcd_barrier_complete(bar, b.x, nloc, nx); b.st[0] = nloc; b.st[1] = nx; }
        const unsigned old = xb_add(&bar[XB_XSUB(b.x)], 1u);
        const unsigned gen = old / nloc;
        if (old + 1u == (gen + 1u) * nloc) {
            __builtin_amdgcn_fence(__ATOMIC_RELEASE, "agent");
            asm volatile("s_waitcnt vmcnt(0)" ::: "memory");
            const unsigned og = xb_add(&bar[XB_TOP], 1u);
            const unsigned tg = og / nx;
            if (og + 1u == (tg + 1u) * nx) xb_add(&bar[XB_TOPGEN], 1u);
            else XB_SPIN(xb_ld(&bar[XB_TOPGEN]) == tg, bar);
            __builtin_amdgcn_fence(__ATOMIC_ACQUIRE, "agent");
            xb_add(&bar[XB_XGEN(b.x)], 1u);
            asm volatile("s_waitcnt vmcnt(0)" ::: "memory");
        } else {
            XB_SPIN(xb_ld(&bar[XB_XGEN(b.x)]) == gen, bar);
            __builtin_amdgcn_fence(__ATOMIC_ACQUIRE, "agent");
            asm volatile("s_waitcnt vmcnt(0)" ::: "memory");
        }
    }
    __syncthreads();
}

__global__ void __launch_bounds__(512, 2) mega(Params p) {
    extern __shared__ __attribute__((aligned(16))) unsigned char shm[];
    cg::grid_group grid = cg::this_grid();
    volatile LAS unsigned* xst = (volatile LAS unsigned*)(LAS unsigned char*)(shm + 131072);
    unsigned* bar = (unsigned*)(p.ws + OFF_BAR);
    const int wv = __builtin_amdgcn_readfirstlane((int)(threadIdx.x >> 6));
    if (wv == 0 && lane_id_v() == 0) { xst[0] = 0u; xst[1] = 0u; }
    if (blockIdx.x == 0) { for (int i = TIDX(wv); i < XCD_BAR_WORDS; i += 512) bar[i] = 0u; }
    __syncthreads();
    unsigned char* ws = p.ws;
    float* mod = (float*)(ws + OFF_MOD);
    float* xc = (float*)(ws + OFF_XC);
    bf16_t* hbuf = (bf16_t*)(ws + OFF_H);
    bf16_t* act = (bf16_t*)(ws + OFF_ACT);
#ifndef PH_MASK
#define PH_MASK 0x3fff
#endif
#define PHASE(k) if ((PH_MASK >> (k)) & 1)
#define SYNC(k) xcd_barrier(xb, wv)
    PHASE(0) { phase_prep(p, shm, wv); }
    grid.sync();
    const XcdBarrier xb = xcd_barrier_post(bar, xst, wv);
    PHASE(1) { phase_norm(p, 0, p.n1g, 0, MALL, wv); } SYNC(1);
    PHASE(2) { { EpiSwiglu E; E.O = act; run_gemm(shm, hbuf, (const bf16_t*)(ws + OFF_WF1IN), MALL, 2 * DFF, DM, E, wv, -1, LDH, LDH); }
               const int extra = (MALL / 256) * (2 * DFF / 256) - 11 * (int)gridDim.x;
               if (gridDim.x == 256 && (int)blockIdx.x >= extra) { const int t0 = (int)blockIdx.x - extra, ts = (int)gridDim.x - extra;
                   convert_w(p.f2in, (bf16_t*)(ws + OFF_WF2IN), DM, 2 * DFF, 1, shm, wv, t0, ts, LDH); convert_w(p.f2out, (bf16_t*)(ws + OFF_WF2OUT), DFF, DM, 0, shm, wv, t0, ts); }
               else if (gridDim.x != 256) { convert_w(p.f2in, (bf16_t*)(ws + OFF_WF2IN), DM, 2 * DFF, 1, shm, wv, (int)blockIdx.x, (int)gridDim.x, LDH); convert_w(p.f2out, (bf16_t*)(ws + OFF_WF2OUT), DFF, DM, 0, shm, wv, (int)blockIdx.x, (int)gridDim.x); } } SYNC(2);
    PHASE(3) { { EpiResidB<true, false> E; E.basef = p.x; E.baseb = nullptr; E.outf = nullptr; E.outb = (bf16_t*)(ws + OFF_XB); E.mod = mod; E.gidx = 2; E.coef = 0.5f;
                 run_gemm(shm, act, (const bf16_t*)(ws + OFF_WF1OUT), NLAT, DM, DFF, E, wv); }
               { EpiPartial E; E.part = xc;
                 run_gemm_splitk<EpiPartial, 2>(shm, act + (size_t)NLAT * DFF, (const bf16_t*)(ws + OFF_WF1OUT), DM, DFF, 11, E, wv); } } SYNC(3);
    PHASE(4) { phase_norm_b(p, p.n2g, 3, wv); phase_norm_ctx(p, wv); } SYNC(4);
    PHASE(5) { { EpiProj E; E.O = (bf16_t*)(ws + OFF_PROJ); E.rcos = (const float*)(ws + OFF_RCOS); E.rsin = (const float*)(ws + OFF_RSIN);
                 run_gemm(shm, hbuf, (const bf16_t*)(ws + OFF_WMIXIN), MALL, 3840, DM, E, wv, -1, LDH, LDH); }
               { EpiKrPart E; E.part = p.out + 16777216;
                 run_gemm_splitk<EpiKrPart, 66>(shm, hbuf, (const bf16_t*)(ws + OFF_WMIXIN) + (size_t)3840 * LDH, 256, DM, 4, E, wv, LDH, (int)((blockIdx.x + 34) % gridDim.x)); } } SYNC(5);
    PHASE(6) { phase_tok(p, wv); phase_ret_kv(p, shm, wv); } SYNC(6);
    PHASE(7) { phase_scan(p, wv);
               { EpiQ E; E.Q = (bf16_t*)(ws + OFF_Q); E.axc = (const float*)(ws + OFF_ACOS); E.axs = (const float*)(ws + OFF_ASIN);
                 run_gemm(shm, (const bf16_t*)(ws + OFF_CQN), (const bf16_t*)(ws + OFF_WUQ), NLAT, 1536, 512, E, wv); }
               { EpiKV E; E.Kd = (bf16_t*)(ws + OFF_K); E.Vd = (bf16_t*)(ws + OFF_V); E.pm0 = 0;
                 run_gemm(shm, (const bf16_t*)(ws + OFF_CKVN), (const bf16_t*)(ws + OFF_WUKV), NLAT, 2048, 256, E, wv);
                 E.pm0 = 64;
                 run_gemm(shm, (const bf16_t*)(ws + OFF_CKVN) + (size_t)NLAT * 256, (const bf16_t*)(ws + OFF_WUKV), 512, 2048, 256, E, wv, (int)((blockIdx.x + gridDim.x / 2) % gridDim.x)); } } SYNC(7);
    PHASE(8) {
#ifndef NO_ATT
        for (int u = blockIdx.x; u < 512; u += gridDim.x) {
            const int b = u >> 8, rem = u & 255, h = rem & 7, qb = rem >> 3;
            const bf16_t* Qb = (const bf16_t*)(ws + OFF_Q) + (size_t)(b * 8192 + qb * 256) * 1536 + h * 192;
            const bf16_t* Kh = (const bf16_t*)(ws + OFF_K) + (size_t)(b * 8 + h) * SKV * 192;
            const bf16_t* Vh = (const bf16_t*)(ws + OFF_V) + (size_t)(b * 8 + h) * SKV * 128;
            bf16_t* Ob = hbuf + (size_t)(b * 8192 + qb * 256) * LDH + 1024 + h * 128;
            __syncthreads();
            att::attn_body(Qb, Kh, Vh, Ob, SKV, (char*)shm, wv);
        }
#endif
#ifndef NO_RET3
        for (int u = blockIdx.x; u < 1024; u += gridDim.x) { __syncthreads(); ret_out_unit(p, shm, u, wv); }
#endif
    } SYNC(8);
    PHASE(9) { EpiResidB<false, false> E; E.basef = nullptr; E.baseb = (const bf16_t*)(ws + OFF_XB); E.outf = nullptr; E.outb = (bf16_t*)(ws + OFF_XB); E.mod = mod; E.gidx = 5; E.coef = 1.0f;
               run_gemm(shm, hbuf, (const bf16_t*)(ws + OFF_WMIXOUT), NLAT, DM, DM, E, wv, -1, LDH, LDH); } SYNC(9);
    PHASE(10) { phase_norm_b(p, p.n3g, 6, wv); } SYNC(10);
    PHASE(11) { EpiSwiglu E; E.O = act; run_gemm(shm, hbuf, (const bf16_t*)(ws + OFF_WF2IN), NLAT, 2 * DFF, DM, E, wv, -1, LDH, LDH); } SYNC(11);
    PHASE(12) { EpiResidB<false, true> E; E.basef = nullptr; E.baseb = (const bf16_t*)(ws + OFF_XB); E.outf = p.out; E.outb = nullptr; E.mod = mod; E.gidx = 8; E.coef = 0.5f;
                run_gemm(shm, act, (const bf16_t*)(ws + OFF_WF2OUT), NLAT, DM, DFF, E, wv); } SYNC(12);
    PHASE(13) { phase_final(p, wv); }
#undef PHASE
#undef SYNC
}

extern "C" void kernel_launch(void* const* d_in, const int* in_sizes, int n_in, void* d_out, int out_size, void* d_ws, size_t ws_size, hipStream_t stream) {
    static int grid_blocks = 0;
    if (!grid_blocks) {
        if (n_in != 22 || ws_size < WS_END || out_size != NLAT * DM) { fprintf(stderr, "kernel_launch: unexpected shapes n_in %d ws %zu (need %zu) out %d\n", n_in, ws_size, (size_t)WS_END, out_size); return; }
        if (hipFuncSetAttribute((const void*)mega, hipFuncAttributeMaxDynamicSharedMemorySize, LDS_BYTES) != hipSuccess) { fprintf(stderr, "kernel_launch: hipFuncSetAttribute failed\n"); return; }
        int dev = 0, cus = 0, per_cu = 0;
        hipGetDevice(&dev);
        hipDeviceGetAttribute(&cus, hipDeviceAttributeMultiprocessorCount, dev);
        hipOccupancyMaxActiveBlocksPerMultiprocessor(&per_cu, mega, 512, LDS_BYTES);
        if (per_cu < 1) { fprintf(stderr, "kernel_launch: occupancy 0\n"); return; }
        grid_blocks = cus;
    }
    Params p{};
    p.x = (const float*)d_in[0]; p.c = (const float*)d_in[1]; p.ctx = (const float*)d_in[2]; p.c_ctx = (const float*)d_in[3]; p.ada_w = (const float*)d_in[4]; p.ada_b = (const float*)d_in[5];
    p.n1g = (const float*)d_in[6]; p.f1in = (const float*)d_in[7]; p.f1out = (const float*)d_in[8]; p.n2g = (const float*)d_in[9]; p.mixin = (const float*)d_in[10];
    p.rdf = (const float*)d_in[11]; p.rdb = (const float*)d_in[12]; p.qng = (const float*)d_in[13]; p.wuq = (const float*)d_in[14]; p.kvng = (const float*)d_in[15]; p.wukv = (const float*)d_in[16];
    p.mixout = (const float*)d_in[17]; p.n3g = (const float*)d_in[18]; p.f2in = (const float*)d_in[19]; p.f2out = (const float*)d_in[20]; p.fng = (const float*)d_in[21];
    p.out = (float*)d_out; p.ws = (unsigned char*)d_ws;
    void* args[] = {&p};
    hipError_t e = hipLaunchCooperativeKernel((void*)mega, dim3(grid_blocks), dim3(512), args, LDS_BYTES, stream);
    if (e != hipSuccess) fprintf(stderr, "cooperative launch failed: %s (grid %d)\n", hipGetErrorString(e), grid_blocks);
}
```
